# Optimizing an MI355X kernel written in HIP

```python
import jax, jax.numpy as jnp
from jax import lax
import numpy as np

D_MODEL = 1024
BATCH = 4
SEQ = 8192
DEPTH = 1

GRID_W = 64
MEM_LEN = 256
MEM_HEADS = 4
MEM_HEAD_DIM = 128
MEM_DIM = MEM_HEADS * MEM_HEAD_DIM
N_FOURIER_GROUPS = 4
FOURIER_GROUP_DIM = 128
FOURIER_DIM = N_FOURIER_GROUPS * FOURIER_GROUP_DIM
NA_HEADS = 8
NA_HEAD_DIM = 64
NA_DIM = NA_HEADS * NA_HEAD_DIM
NA_ROW_WIN = 8
NA_COL_WIN = 16
N_BRANCHES = 3
IN_PROJ_DIM = FOURIER_DIM + 3 * NA_DIM + MEM_DIM
N_GROUPS = 8
EXPERTS_PER_GROUP = 8
N_EXPERTS = N_GROUPS * EXPERTS_PER_GROUP
TOP_K = 2
D_EXPERT = 512
MOE_BLOCK = 128
ALPHA = (2.0 * DEPTH) ** 0.25
BETA = (8.0 * DEPTH) ** -0.25
LN_EPS = 1e-5

kernel_name = 'hybrid_fnet_natten_memory_hmoe_encoder'


def layer_norm(x, g, b):
    xf = x.astype(jnp.float32)
    mu = xf.mean(-1, keepdims=True)
    var = jnp.square(xf - mu).mean(-1, keepdims=True)
    y = (xf - mu) * lax.rsqrt(var + LN_EPS) * g.astype(jnp.float32) + b.astype(jnp.float32)
    return y.astype(x.dtype)


def fourier_mix(u):
    b, s, _ = u.shape
    ug = u.astype(jnp.float32).reshape(b, s, N_FOURIER_GROUPS, FOURIER_GROUP_DIM)
    y = jnp.fft.fft2(ug, axes=(1, 3), norm='ortho').real
    return y.reshape(b, s, FOURIER_DIM).astype(u.dtype)


def neighbourhood_attention(q, k, v, rpb):
    b, s = q.shape[0], q.shape[1]
    rows = s // GRID_W
    kr = min(NA_ROW_WIN, rows)

    def to_grid(t):
        return t.reshape(b, rows, GRID_W, NA_HEADS, NA_HEAD_DIM).transpose(0, 3, 1, 2, 4)

    qg, kg, vg = to_grid(q), to_grid(k), to_grid(v)
    cols = np.arange(GRID_W)
    col_start = np.clip(cols - NA_COL_WIN // 2, 0, GRID_W - NA_COL_WIN)
    col_idx = col_start[:, None] + np.arange(NA_COL_WIN)[None, :]
    dc_idx = col_idx - cols[:, None] + (NA_COL_WIN - 1)
    bias_c = rpb[:, :, dc_idx]
    scale = NA_HEAD_DIM ** -0.5

    def one_row(r):
        rs = jnp.clip(r - kr // 2, 0, rows - kr)
        q_r = lax.dynamic_index_in_dim(qg, r, axis=2, keepdims=False)
        k_rows = lax.dynamic_slice_in_dim(kg, rs, kr, axis=2)
        v_rows = lax.dynamic_slice_in_dim(vg, rs, kr, axis=2)
        k_win = k_rows[:, :, :, col_idx]
        v_win = v_rows[:, :, :, col_idx]
        dr_idx = rs + jnp.arange(kr) - r + (NA_ROW_WIN - 1)
        bias = bias_c[:, dr_idx].transpose(0, 2, 1, 3)
        sc = jnp.einsum('bhcd,bhrckd->bhcrk', q_r, k_win).astype(jnp.float32) * scale
        sc = sc + bias[None].astype(jnp.float32)
        p = jax.nn.softmax(sc.reshape(b, NA_HEADS, GRID_W, kr * NA_COL_WIN), axis=-1)
        p = p.reshape(b, NA_HEADS, GRID_W, kr, NA_COL_WIN).astype(v.dtype)
        return jnp.einsum('bhcrk,bhrckd->bhcd', p, v_win)

    out = lax.map(one_row, jnp.arange(rows))
    return out.transpose(1, 0, 3, 2, 4).reshape(b, s, NA_DIM)


def memory_attention(q, k, v):
    b, s = q.shape[0], q.shape[1]
    sc = jnp.einsum('bshd,bmhd->bhsm', q, k).astype(jnp.float32) * (MEM_HEAD_DIM ** -0.5)
    p = jax.nn.softmax(sc, axis=-1).astype(v.dtype)
    return jnp.einsum('bhsm,bmhd->bshd', p, v).reshape(b, s, MEM_DIM)


def token_mixing(x, mem, w_in, w_gate, b_gate, w_mem_kv, rpb, w_fourier_o, w_na_o, w_mem_o, w_out):
    b, s, d = x.shape
    proj = x @ w_in
    o1 = FOURIER_DIM
    o2 = o1 + NA_DIM
    o3 = o2 + NA_DIM
    o4 = o3 + NA_DIM
    u_f = proj[..., :o1]
    q_na = proj[..., o1:o2].reshape(b, s, NA_HEADS, NA_HEAD_DIM)
    k_na = proj[..., o2:o3].reshape(b, s, NA_HEADS, NA_HEAD_DIM)
    v_na = proj[..., o3:o4].reshape(b, s, NA_HEADS, NA_HEAD_DIM)
    q_mem = proj[..., o4:].reshape(b, s, MEM_HEADS, MEM_HEAD_DIM)
    kv = mem @ w_mem_kv
    m = mem.shape[1]
    k_mem = kv[..., :MEM_DIM].reshape(b, m, MEM_HEADS, MEM_HEAD_DIM)
    v_mem = kv[..., MEM_DIM:].reshape(b, m, MEM_HEADS, MEM_HEAD_DIM)
    br_f = fourier_mix(u_f) @ w_fourier_o
    br_na = neighbourhood_attention(q_na, k_na, v_na, rpb) @ w_na_o
    br_mem = memory_attention(q_mem, k_mem, v_mem) @ w_mem_o
    gates = jax.nn.sigmoid(x @ w_gate + b_gate).reshape(b, s, N_BRANCHES, d)
    merged = gates[:, :, 0] * br_f + gates[:, :, 1] * br_na + gates[:, :, 2] * br_mem
    return merged @ w_out


def hierarchical_moe(h, w_rg, b_rg, w_re, b_re, w_eg, w_eu, w_ed):
    b, s, d = h.shape
    t = b * s
    tok = h.reshape(t, d)
    tf = tok.astype(jnp.float32)
    group_logits = tf @ w_rg.astype(jnp.float32) + b_rg.astype(jnp.float32)
    group_prob = jax.nn.softmax(group_logits, axis=-1)
    g_idx = jnp.argmax(group_logits, axis=-1).astype(jnp.int32)
    p_group = jnp.take_along_axis(group_prob, g_idx[:, None], axis=1)
    exp_logits = (tf @ w_re.astype(jnp.float32) + b_re.astype(jnp.float32)).reshape(t, N_GROUPS, EXPERTS_PER_GROUP)
    exp_logits = jnp.take_along_axis(exp_logits, g_idx[:, None, None], axis=1)[:, 0]
    top_val, top_idx = lax.top_k(exp_logits, TOP_K)
    weights = (jax.nn.softmax(top_val, axis=-1) * p_group).reshape(-1)
    expert = (g_idx[:, None] * EXPERTS_PER_GROUP + top_idx).reshape(-1).astype(jnp.int32)
    token = jnp.repeat(jnp.arange(t, dtype=jnp.int32), TOP_K)
    n_assign = t * TOP_K
    order = jnp.argsort(expert)
    e_sorted = expert[order]
    counts = jnp.bincount(expert, length=N_EXPERTS)
    start = jnp.cumsum(counts) - counts
    padded = (counts + MOE_BLOCK - 1) // MOE_BLOCK * MOE_BLOCK
    pad_end = jnp.cumsum(padded)
    pad_start = pad_end - padded
    dest = pad_start[e_sorted] + jnp.arange(n_assign, dtype=jnp.int32) - start[e_sorted]
    n_pad = n_assign + N_EXPERTS * MOE_BLOCK
    n_blocks = n_pad // MOE_BLOCK
    pad_tok = jnp.full((n_pad,), t, jnp.int32).at[dest].set(token[order])
    pad_w = jnp.zeros((n_pad,), jnp.float32).at[dest].set(weights[order])
    block_start = jnp.arange(n_blocks, dtype=jnp.int32) * MOE_BLOCK
    block_expert = jnp.clip(jnp.searchsorted(pad_end, block_start, side='right'), 0, N_EXPERTS - 1)
    tok_pad = jnp.concatenate([tok, jnp.zeros((1, d), tok.dtype)], axis=0)
    xg = tok_pad[pad_tok].reshape(n_blocks, MOE_BLOCK, d)

    def expert_block(args):
        xb, e = args
        return (jax.nn.silu(xb @ w_eg[e]) * (xb @ w_eu[e])) @ w_ed[e]

    yb = lax.map(expert_block, (xg, block_expert)).reshape(n_pad, d)
    y = jax.ops.segment_sum(yb * pad_w[:, None].astype(yb.dtype), pad_tok, num_segments=t + 1)[:t]
    return y.reshape(b, s, d)


def setup_inputs(seed: int = 0) -> dict:
    key = jax.random.key(seed)
    ks = jax.random.split(key, 32)
    L = DEPTH
    sd = D_MODEL ** -0.5

    def nrm(k, shape, scale):
        return jax.random.normal(k, shape, jnp.float32) * scale

    x = nrm(ks[0], (BATCH, SEQ, D_MODEL), 1.0)
    mem = nrm(ks[1], (BATCH, MEM_LEN, D_MODEL), 1.0)
    w_in = jnp.concatenate([
        nrm(ks[2], (L, D_MODEL, FOURIER_DIM + 2 * NA_DIM), sd),
        nrm(ks[3], (L, D_MODEL, NA_DIM), sd * BETA),
        nrm(ks[4], (L, D_MODEL, MEM_DIM), sd)], axis=-1)
    w_gate = nrm(ks[5], (L, D_MODEL, N_BRANCHES * D_MODEL), sd)
    b_gate = nrm(ks[6], (L, N_BRANCHES * D_MODEL), 0.02)
    w_mem_kv = jnp.concatenate([
        nrm(ks[7], (L, D_MODEL, MEM_DIM), sd),
        nrm(ks[8], (L, D_MODEL, MEM_DIM), sd * BETA)], axis=-1)
    rpb = nrm(ks[9], (L, NA_HEADS, 2 * NA_ROW_WIN - 1, 2 * NA_COL_WIN - 1), 0.02)
    w_fourier_o = nrm(ks[10], (L, FOURIER_DIM, D_MODEL), FOURIER_DIM ** -0.5 * BETA)
    w_na_o = nrm(ks[11], (L, NA_DIM, D_MODEL), NA_DIM ** -0.5 * BETA)
    w_mem_o = nrm(ks[12], (L, MEM_DIM, D_MODEL), MEM_DIM ** -0.5 * BETA)
    w_out = nrm(ks[13], (L, D_MODEL, D_MODEL), sd * BETA)
    ln1_g = 1.0 + nrm(ks[14], (L, D_MODEL), 0.02)
    ln1_b = nrm(ks[15], (L, D_MODEL), 0.02)
    w_router_group = nrm(ks[16], (L, D_MODEL, N_GROUPS), sd)
    b_router_group = nrm(ks[17], (L, N_GROUPS), 0.01)
    w_router_expert = nrm(ks[18], (L, D_MODEL, N_EXPERTS), sd)
    b_router_expert = nrm(ks[19], (L, N_EXPERTS), 0.01)
    w_exp_gate = nrm(ks[20], (L, N_EXPERTS, D_MODEL, D_EXPERT), sd)
    w_exp_up = nrm(ks[21], (L, N_EXPERTS, D_MODEL, D_EXPERT), sd * BETA)
    w_exp_down = nrm(ks[22], (L, N_EXPERTS, D_EXPERT, D_MODEL), D_EXPERT ** -0.5 * BETA)
    ln2_g = 1.0 + nrm(ks[23], (L, D_MODEL), 0.02)
    ln2_b = nrm(ks[24], (L, D_MODEL), 0.02)
    return {'x': x, 'mem': mem, 'w_in': w_in, 'w_gate': w_gate, 'b_gate': b_gate,
            'w_mem_kv': w_mem_kv, 'rpb': rpb, 'w_fourier_o': w_fourier_o, 'w_na_o': w_na_o,
            'w_mem_o': w_mem_o, 'w_out': w_out, 'ln1_g': ln1_g, 'ln1_b': ln1_b,
            'w_router_group': w_router_group, 'b_router_group': b_router_group,
            'w_router_expert': w_router_expert, 'b_router_expert': b_router_expert,
            'w_exp_gate': w_exp_gate, 'w_exp_up': w_exp_up, 'w_exp_down': w_exp_down,
            'ln2_g': ln2_g, 'ln2_b': ln2_b}


def reference(x, mem, w_in, w_gate, b_gate, w_mem_kv, rpb, w_fourier_o, w_na_o, w_mem_o,
              w_out, ln1_g, ln1_b, w_router_group, b_router_group, w_router_expert,
              b_router_expert, w_exp_gate, w_exp_up, w_exp_down, ln2_g, ln2_b):
    for l in range(DEPTH):
        mix = token_mixing(x, mem, w_in[l], w_gate[l], b_gate[l], w_mem_kv[l], rpb[l],
                           w_fourier_o[l], w_na_o[l], w_mem_o[l], w_out[l])
        h = layer_norm(ALPHA * x + mix, ln1_g[l], ln1_b[l])
        ffn = hierarchical_moe(h, w_router_group[l], b_router_group[l], w_router_expert[l],
                               b_router_expert[l], w_exp_gate[l], w_exp_up[l], w_exp_down[l])
        x = layer_norm(ALPHA * h + ffn, ln2_g[l], ln2_b[l])
    return x
```

```cpp
#include <hip/hip_runtime.h>
#include <cstdio>
#include <cstdint>

#define DI __device__ __forceinline__
#define LAS __attribute__((address_space(3)))
#define GAS __attribute__((address_space(1)))
typedef unsigned short bf16_t;
typedef short bf16x8 __attribute__((ext_vector_type(8)));
typedef float f32x4 __attribute__((ext_vector_type(4)));
typedef float f32x2 __attribute__((ext_vector_type(2)));
typedef unsigned u32x4 __attribute__((ext_vector_type(4)));
typedef unsigned u32x2 __attribute__((ext_vector_type(2)));

constexpr int T = 32768, DM = 1024, NBATCH = 4, SEQ = 8192, MEML = 256;
constexpr int NEXP = 64, DEXP = 512;
constexpr float ALPHA = 1.189207115002721f;
constexpr float LN_EPS = 1e-5f;
constexpr int LIST_CAP = 32768;

constexpr size_t MiB = 1u << 20;
constexpr size_t WS_CTL = 0, CTL_ZERO_BYTES = 1 * MiB;
constexpr size_t WS_W1T = 1 * MiB;
constexpr size_t WS_WKVT = 13 * MiB;
constexpr size_t WS_WFOT = 15 * MiB, WS_WNAT = 16 * MiB, WS_WMOT = 17 * MiB;
constexpr size_t WS_WOUTT = 18 * MiB;
constexpr size_t WS_WRT = 20 * MiB;
constexpr size_t WS_F64 = 20 * MiB + 256 * 1024;
constexpr size_t WS_C128 = 20 * MiB + 320 * 1024;
constexpr size_t WS_LIST = 21 * MiB;
constexpr size_t WS_REC = 29 * MiB;
constexpr size_t WS_R1 = 30 * MiB;
constexpr size_t WS_R2 = 94 * MiB;
constexpr size_t WS_R3 = 158 * MiB;
constexpr size_t WS_R4 = 222 * MiB;
constexpr size_t WS_R5 = 286 * MiB;
constexpr size_t WS_R6 = 350 * MiB;
constexpr size_t WS_KVM = 542 * MiB;
constexpr size_t WS_MEMB = 544 * MiB;
constexpr size_t WS_END = 546 * MiB;
constexpr size_t WS_XB = WS_R1, WS_T1 = WS_R1, WS_H = WS_R1;
constexpr size_t WS_ZT = WS_R2, WS_Y = WS_R4 + 32 * MiB;
constexpr size_t WS_Q = WS_R3, WS_K = WS_R3 + 32 * MiB, WS_MERGED = WS_R3;
constexpr size_t WS_VT = WS_R4, WS_QM = WS_R4 + 32 * MiB;
constexpr size_t WS_ONA = WS_R5, WS_OMEM = WS_R5 + 32 * MiB;
constexpr size_t WS_GATES = WS_R6, WS_WGUT = WS_R6, WS_WDT = WS_R6 + 128 * MiB;
constexpr size_t WS_V = WS_R4;
constexpr size_t WS_HMOE = 270 * MiB;
constexpr size_t WS_YB = 94 * MiB;
constexpr int CW_BAR = 4096;
constexpr int CW_GCNT = 8192;

constexpr int RING_BYTES = 131072;
constexpr int MISC_OFF = RING_BYTES;
constexpr int LDS_BYTES = 147456;
constexpr int MS_BAR = 0, MS_TSTART = 64, MS_CNT = 512, MS_TILEE = 1024, MS_HIST = 2048, MS_BASE = 2560;

DI unsigned pk2(float lo, float hi) {
    typedef __bf16 bf2 __attribute__((ext_vector_type(2)));
    f32x2 v = {lo, hi};
    bf2 r = __builtin_convertvector(v, bf2);
    return __builtin_bit_cast(unsigned, r);
}
DI float bf_lo(unsigned w) { return __uint_as_float(w << 16); }
DI float bf_hi(unsigned w) { return __uint_as_float(w & 0xffff0000u); }
DI float wave_sum(float v) {
#pragma unroll
    for (int o = 1; o < 64; o <<= 1) v += __shfl_xor(v, o);
    return v;
}
DI float fast_sigmoid(float z) { return __builtin_amdgcn_rcpf(1.0f + __builtin_amdgcn_exp2f(-1.4426950408889634f * z)); }
#define LDS_WAIT() asm volatile("s_waitcnt lgkmcnt(0)" ::: "memory")
#define VM_WAIT() asm volatile("s_waitcnt vmcnt(0)" ::: "memory")

#define XB_TMO      128
#define XB_XCNT(j)  (256  + 64 * (j))
#define XB_XSUB(j)  (1280 + 64 * (j))
#define XB_XGEN(j)  (2304 + 64 * (j))
#define XB_TOP      3328
#define XB_TOPGEN   3392
#define XCD_BAR_WORDS 3456
#define XB_SPIN_CAP (1u << 18)

__device__ __forceinline__ unsigned xb_ld(unsigned* p)              { return __hip_atomic_load(p, __ATOMIC_RELAXED, __HIP_MEMORY_SCOPE_AGENT); }
__device__ __forceinline__ unsigned xb_add(unsigned* p, unsigned v) { return __hip_atomic_fetch_add(p, v, __ATOMIC_RELAXED, __HIP_MEMORY_SCOPE_AGENT); }
__device__ __forceinline__ unsigned xb_xcc_id() { return (unsigned)__builtin_amdgcn_s_getreg((3 << 11) | 20) & 0xFu; }
#define XB_SPIN(cond, bar) do { unsigned _sp = 0; while (cond) { __builtin_amdgcn_s_sleep(1); \
    if ((++_sp & 255u) == 0u) { if (xb_ld(&(bar)[XB_TMO])) break; if (_sp > XB_SPIN_CAP) { atomicAdd(&(bar)[XB_TMO], 1u); break; } } } } while (0)

struct XcdBarrier {
    unsigned* bar; unsigned x;
    volatile LAS unsigned* st;
};
__device__ __forceinline__ XcdBarrier xcd_barrier_post(unsigned* bar, volatile LAS unsigned* st) {
    XcdBarrier b; b.bar = bar; b.x = xb_xcc_id(); b.st = st;
    if (threadIdx.x == 0) (void)xb_add(&bar[XB_XCNT(b.x)], 1u);
    return b;
}
__device__ __forceinline__ void xcd_barrier_complete(unsigned* bar, unsigned x, unsigned& nloc, unsigned& nx) {
    const unsigned G = gridDim.x * gridDim.y * gridDim.z;
    unsigned sum, cnt, mine, sp = 0u;
    for (;;) {
        sum = 0u; cnt = 0u; mine = 0u;
#pragma unroll
        for (unsigned j = 0; j < 16; ++j) { const unsigned c = xb_ld(&bar[XB_XCNT(j)]); sum += c; cnt += (c > 0u) ? 1u : 0u; mine = (j == x) ? c : mine; }
        if (sum == G) break;
        __builtin_amdgcn_s_sleep(1);
        if ((++sp & 255u) == 0u) { if (xb_ld(&bar[XB_TMO])) break; if (sp > XB_SPIN_CAP) { atomicAdd(&bar[XB_TMO], 1u); break; } }
    }
    nloc = mine > 0u ? mine : 1u; nx = cnt > 0u ? cnt : 1u;
}
__device__ __forceinline__ void xcd_barrier(const XcdBarrier& b) {
    asm volatile("s_waitcnt vmcnt(0)" ::: "memory");
    __syncthreads();
    if (threadIdx.x == 0) {
        unsigned* bar = b.bar;
        __builtin_amdgcn_s_waitcnt(0);
        unsigned nloc = b.st[0], nx = b.st[1];
        if (nloc == 0u) { xcd_barrier_complete(bar, b.x, nloc, nx); b.st[0] = nloc; b.st[1] = nx; }
        const unsigned old = xb_add(&bar[XB_XSUB(b.x)], 1u);
        const unsigned gen = old / nloc;
        if (old + 1u == (gen + 1u) * nloc) {
            __builtin_amdgcn_fence(__ATOMIC_RELEASE, "agent");
            asm volatile("s_waitcnt vmcnt(0)" ::: "memory");
            const unsigned og = xb_add(&bar[XB_TOP], 1u);
            const unsigned tg = og / nx;
            if (og + 1u == (tg + 1u) * nx) xb_add(&bar[XB_TOPGEN], 1u);
            else XB_SPIN(xb_ld(&bar[XB_TOPGEN]) == tg, bar);
            __builtin_amdgcn_fence(__ATOMIC_ACQUIRE, "agent");
            xb_add(&bar[XB_XGEN(b.x)], 1u);
            asm volatile("s_waitcnt vmcnt(0)" ::: "memory");
        } else {
            XB_SPIN(xb_ld(&bar[XB_XGEN(b.x)]) == gen, bar);
            __builtin_amdgcn_fence(__ATOMIC_ACQUIRE, "agent");
            asm volatile("s_waitcnt vmcnt(0)" ::: "memory");
        }
    }
    __syncthreads();
}

namespace pg8 {
constexpr int BM = 256, BK = 64, HALF = 128, HTB = HALF * BK * 2, STAGE_BYTES = 8 * HTB;
DI int lds_byte(int r, int c) { const int st = (r >> 4) * 2 + (c >> 5), rr = r & 15, cc = c & 31, ob = rr * 64 + cc * 2; return st * 1024 + (ob ^ (((ob >> 9) & 1) << 5)); }
DI void stage_rc(int b, int& R, int& C) { const int st = b / 1024, sb = b % 1024, swz = sb ^ (((sb >> 9) & 1) << 5); R = (st >> 1) * 16 + swz / 64; C = (st & 1) * 32 + (swz % 64) / 2; }
DI int perm32(int rho) { const int n = rho >> 4, i = rho & 15; return 8 * (i >> 2) + 4 * n + (i & 3); }

struct GU { const char* A; const char* B; int p0, p1, p2, p3; };
typedef f32x4 Acc[2][2][4][2];

DI void tile_order(int L, int nM, int nN, int& pm, int& pn) {
    const int nwg = nM * nN; int wgid = L;
    { const int q = nwg / 8, r = nwg % 8, xcd = wgid % 8, off = wgid / 8; wgid = (xcd < r ? xcd * (q + 1) : r * (q + 1) + (xcd - r) * q) + off; }
    const int nig = 8 * nN, gid = wgid / nig, fm = gid * 8, gsz = (nM - fm) < 8 ? (nM - fm) : 8;
    pm = fm + ((wgid % nig) % gsz); pn = (wgid % nig) / gsz;
}

template <class Epi, class Sched>
DI void gemm_phase(LAS unsigned char* lds, const Sched& S, const Epi& E) {
    const int tid = threadIdx.x, wid = __builtin_amdgcn_readfirstlane(tid >> 6), lane = tid & 63, wr = wid >> 2, wc = wid & 3, fr = lane & 15, fq = lane >> 4;
    const int K = S.K, nt = K / BK;
    int Rs[2], Cs[2];
    unsigned voffB[2], vA[2][2], nA_[2][2];
#pragma unroll
    for (int i = 0; i < 2; ++i) { stage_rc(tid * 16 + i * 8192, Rs[i], Cs[i]); const int Rb = Epi::PERM ? ((Rs[i] & ~31) + perm32(Rs[i] & 31)) : Rs[i];
        voffB[i] = S.rowoffB(Rb) + (unsigned)Cs[i] * 2u;
        vA[0][i] = S.rowoffA(Rs[i]) + (unsigned)Cs[i] * 2u; vA[1][i] = vA[0][i] + S.hstepA(); nA_[0][i] = vA[0][i]; nA_[1][i] = vA[1][i]; }
    const size_t kstep = (size_t)(BK * 2);
    const size_t hstepB = S.hstepB();
    const unsigned ldsw = (unsigned)wid * 1024u;
    const int aoff = lds_byte(wr * 64 + fr, fq * 8), boff = lds_byte(wc * 32 + fr, fq * 8);
#define PG8_SA(b, h) (((b) * 2 + (h)) * HTB)
#define PG8_SB(b, h) ((4 + (b) * 2 + (h)) * HTB)
#define PG8_STAGE2(bufoff, gbase, v0, v1) do { \
        __builtin_amdgcn_global_load_lds((const unsigned*)((const char*)(gbase) + (v0)), (LAS unsigned*)(lds + (bufoff) + ldsw), 16, 0, 0); \
        __builtin_amdgcn_global_load_lds((const unsigned*)((const char*)(gbase) + (v1)), (LAS unsigned*)(lds + (bufoff) + ldsw + 8192), 16, 0, 0); } while (0)
#define PG8_STAGEB(bufoff, gbase) PG8_STAGE2(bufoff, gbase, voffB[0], voffB[1])
#define PG8_LDA(dst, b, h) do { _Pragma("unroll") for (int m = 0; m < 4; ++m) _Pragma("unroll") for (int k = 0; k < 2; ++k) dst[m][k] = *(const LAS bf16x8*)(lds + PG8_SA(b, h) + aoff + m * 2048 + k * 1024); } while (0)
#define PG8_LDB(dst, b, h) do { _Pragma("unroll") for (int n = 0; n < 2; ++n) _Pragma("unroll") for (int k = 0; k < 2; ++k) dst[n][k] = *(const LAS bf16x8*)(lds + PG8_SB(b, h) + boff + n * 2048 + k * 1024); } while (0)
#define PG8_MMA(ai, bj, At, Bt) do { __builtin_amdgcn_s_setprio(1); _Pragma("unroll") for (int m = 0; m < 4; ++m) _Pragma("unroll") for (int n = 0; n < 2; ++n) _Pragma("unroll") for (int k = 0; k < 2; ++k) \
        acc[ai][bj][m][n] = __builtin_amdgcn_mfma_f32_16x16x32_bf16(Bt[n][k], At[m][k], acc[ai][bj][m][n], 0, 0, 0); __builtin_amdgcn_s_setprio(0); } while (0)
#define PG8_WAIT_V(n) asm volatile("s_waitcnt vmcnt(" #n ")" ::: "memory")
#define PG8_WAIT_L(n) asm volatile("s_waitcnt lgkmcnt(" #n ")" ::: "memory")
#define PG8_BAR __builtin_amdgcn_s_barrier()
#define PG8_SCHED __builtin_amdgcn_sched_barrier(0)
    GU cur, nxt; int ui = 0;
    if (!S.next(0, cur)) return;
    Acc acc;
#pragma unroll
    for (int a = 0; a < 2; ++a)
#pragma unroll
        for (int b = 0; b < 2; ++b)
#pragma unroll
            for (int m = 0; m < 4; ++m)
#pragma unroll
                for (int n = 0; n < 2; ++n) acc[a][b][m][n] = (f32x4){0.f, 0.f, 0.f, 0.f};
    bf16x8 At[4][2], B0[2][2], B1[2][2];
    const char* cA = cur.A; const char* cB = cur.B;
    if constexpr (Sched::GATHER) {
#pragma unroll
        for (int i = 0; i < 2; ++i) { vA[0][i] = S.gatherA(cur, Rs[i]) + (unsigned)Cs[i] * 2u; vA[1][i] = S.gatherA(cur, Rs[i] + 128) + (unsigned)Cs[i] * 2u; }
    }
    PG8_STAGEB(PG8_SB(0, 0), cB); PG8_STAGEB(PG8_SB(0, 1), cB + hstepB); PG8_STAGE2(PG8_SA(0, 0), cA, vA[0][0], vA[0][1]); PG8_STAGE2(PG8_SA(0, 1), cA, vA[1][0], vA[1][1]);
    if (wr == 1) PG8_BAR;
    PG8_WAIT_V(2); PG8_BAR;
    PG8_STAGEB(PG8_SB(1, 0), cB + kstep); PG8_STAGE2(PG8_SA(1, 0), cA + kstep, vA[0][0], vA[0][1]); PG8_STAGEB(PG8_SB(1, 1), cB + hstepB + kstep);
    PG8_WAIT_V(6); PG8_BAR;
    for (;;) {
        const bool has_next = S.next(ui + 1, nxt);
        const char* nA = has_next ? nxt.A : cA; const char* nB = has_next ? nxt.B : cB;
        if constexpr (Sched::GATHER) {
            if (has_next) {
#pragma unroll
                for (int i = 0; i < 2; ++i) { nA_[0][i] = S.gatherA(nxt, Rs[i]) + (unsigned)Cs[i] * 2u; nA_[1][i] = S.gatherA(nxt, Rs[i] + 128) + (unsigned)Cs[i] * 2u; }
            } else {
#pragma unroll
                for (int i = 0; i < 2; ++i) { nA_[0][i] = vA[0][i]; nA_[1][i] = vA[1][i]; }
            }
        }
        for (int t = 0; t < nt; t += 2) {
            const bool last = (t == nt - 2);
            const char* a1 = cA + (size_t)(t + 1) * kstep;
            const char* a2 = last ? nA : cA + (size_t)(t + 2) * kstep; const char* b2 = last ? nB : cB + (size_t)(t + 2) * kstep;
            const char* a3 = a2 + kstep; const char* b3 = b2 + kstep;
            unsigned x00 = vA[0][0], x01 = vA[0][1], x10 = vA[1][0], x11 = vA[1][1];
            if constexpr (Sched::GATHER) { if (last) { x00 = nA_[0][0]; x01 = nA_[0][1]; x10 = nA_[1][0]; x11 = nA_[1][1]; } }
            PG8_LDB(B0, 0, 0); PG8_LDB(B1, 0, 1); PG8_SCHED; PG8_LDA(At, 0, 0); PG8_STAGE2(PG8_SA(1, 1), a1, vA[1][0], vA[1][1]);
            PG8_WAIT_V(8); PG8_WAIT_L(0); PG8_BAR; PG8_MMA(0, 0, At, B0); PG8_MMA(0, 1, At, B1); PG8_BAR; PG8_SCHED;
            PG8_LDA(At, 0, 1); PG8_STAGEB(PG8_SB(0, 0), b2); PG8_STAGEB(PG8_SB(0, 1), b2 + hstepB); PG8_STAGE2(PG8_SA(0, 0), a2, x00, x01);
            PG8_WAIT_V(8); PG8_WAIT_L(0); PG8_BAR; PG8_MMA(1, 0, At, B0); PG8_MMA(1, 1, At, B1); PG8_BAR; PG8_SCHED;
            PG8_LDB(B0, 1, 0); PG8_LDB(B1, 1, 1); PG8_SCHED; PG8_LDA(At, 1, 0); PG8_STAGE2(PG8_SA(0, 1), a2, x10, x11);
            PG8_WAIT_V(8); PG8_WAIT_L(0); PG8_BAR; PG8_MMA(0, 0, At, B0); PG8_MMA(0, 1, At, B1); PG8_BAR; PG8_SCHED;
            PG8_LDA(At, 1, 1); PG8_STAGEB(PG8_SB(1, 0), b3); PG8_STAGEB(PG8_SB(1, 1), b3 + hstepB); PG8_STAGE2(PG8_SA(1, 0), a3, x00, x01);
            PG8_WAIT_V(8); PG8_WAIT_L(0); PG8_BAR; PG8_MMA(1, 0, At, B0); PG8_MMA(1, 1, At, B1); PG8_BAR; PG8_SCHED;
        }
        if (wr == 0) PG8_BAR;
        E(acc, cur, wr, wc, fr, fq);
        if (!has_next) break;
        cur = nxt; cA = nA; cB = nB; ++ui;
        if constexpr (Sched::GATHER) {
#pragma unroll
            for (int i = 0; i < 2; ++i) { vA[0][i] = nA_[0][i]; vA[1][i] = nA_[1][i]; }
        }
        if (wr == 1) PG8_BAR;
    }
    PG8_WAIT_V(0);
    PG8_BAR;
#undef PG8_SA
#undef PG8_SB
#undef PG8_STAGE2
#undef PG8_STAGEB
#undef PG8_LDA
#undef PG8_LDB
#undef PG8_MMA
#undef PG8_WAIT_V
#undef PG8_WAIT_L
#undef PG8_BAR
#undef PG8_SCHED
}
}
using pg8::GU; using pg8::Acc;

struct Args { const float* in[22]; float* out; unsigned char* ws; int ph_lo, ph_hi; };
struct Frame {
    LAS unsigned char* lds;
    int tid, lane, wave, G, vcu;
    unsigned char* ws;
};
enum { IN_X = 0, IN_MEM, IN_WIN, IN_WGATE, IN_BGATE, IN_WMEMKV, IN_RPB, IN_WFO, IN_WNAO, IN_WMEMO, IN_WOUT, IN_LN1G, IN_LN1B,
       IN_WRG, IN_BRG, IN_WRE, IN_BRE, IN_WEG, IN_WEU, IN_WED, IN_LN2G, IN_LN2B };

DI void cvt_row_1024(const float* src, bf16_t* dst, int lane) {
#pragma unroll
    for (int j = 0; j < 2; ++j) {
        const f32x4 a = *(const f32x4*)(src + j * 512 + lane * 8), b = *(const f32x4*)(src + j * 512 + lane * 8 + 4);
        u32x4 o; o.x = pk2(a.x, a.y); o.y = pk2(a.z, a.w); o.z = pk2(b.x, b.y); o.w = pk2(b.z, b.w);
        *(u32x4*)(dst + j * 512 + lane * 8) = o;
    }
}
DI void tr_tile(const float* W, int ldw, int colbase, int k0, bf16_t* WT, int ldt, int drow0, LAS float* scr, int lane) {
#pragma unroll 8
    for (int i = 0; i < 32; ++i) { const int kk = 2 * i + (lane >> 5); scr[kk * 33 + (lane & 31)] = W[(size_t)(k0 + kk) * ldw + colbase + (lane & 31)]; }
    LDS_WAIT(); asm volatile("" ::: "memory");
    const int c = lane & 7;
#pragma unroll
    for (int j = 0; j < 4; ++j) { const int n = (lane >> 3) + 8 * j; const LAS float* s = scr + (8 * c) * 33 + n;
        u32x4 o; o.x = pk2(s[0 * 33], s[1 * 33]); o.y = pk2(s[2 * 33], s[3 * 33]); o.z = pk2(s[4 * 33], s[5 * 33]); o.w = pk2(s[6 * 33], s[7 * 33]);
        *(u32x4*)(WT + (size_t)(drow0 + n) * ldt + k0 + 8 * c) = o; }
    LDS_WAIT(); asm volatile("" ::: "memory");
}
DI void tr_item(const float* W, int ldw, int col0, int ncols, bf16_t* WT, int K, int row_off, LAS float* scr, int item, int lane) {
    const int nblk = ncols / 32, kb = item / nblk, nb = item % nblk;
    tr_tile(W, ldw, col0 + 32 * nb, 64 * kb, WT, K, row_off + 32 * nb, scr, lane);
}
DI void fold_item(const float* w_in, bf16_t* W1t, LAS float* scr, int item, int lane) {
    const int g = item >> 7, k0 = (item & 127) * 8;
    LAS float* wt = scr;
    LAS float* tc = scr + 1024;
    LAS float* ts = scr + 1152;
#pragma unroll
    for (int j = 0; j < 4; ++j) { const int idx = lane + 64 * j, kk = idx >> 5, c4 = idx & 31;
        const f32x4 v = *(const f32x4*)(w_in + (size_t)(k0 + kk) * 2560 + g * 128 + 4 * c4);
        *(LAS f32x4*)(wt + kk * 128 + 4 * c4) = v; }
#pragma unroll
    for (int j = 0; j < 2; ++j) { const int i = lane + 64 * j; float sv, cv; sincospif((float)i * (1.0f / 64.0f), &sv, &cv); tc[i] = cv; ts[i] = sv; }
    LDS_WAIT(); asm volatile("" ::: "memory");
#pragma unroll 1
    for (int j = 0; j < 2; ++j) {
        const int cp = lane + 64 * j;
        float re[8], im[8];
#pragma unroll
        for (int kk = 0; kk < 8; ++kk) { re[kk] = 0.f; im[kk] = 0.f; }
        for (int c = 0; c < 128; ++c) {
            const int idx = (c * cp) & 127; const float cs = tc[idx], sn = ts[idx];
#pragma unroll
            for (int kk = 0; kk < 8; ++kk) { const float w = wt[kk * 128 + c]; re[kk] += w * cs; im[kk] -= w * sn; }
        }
        const float sc = 0.08838834764831845f;
        u32x4 o;
        o.x = pk2(re[0] * sc, re[1] * sc); o.y = pk2(re[2] * sc, re[3] * sc); o.z = pk2(re[4] * sc, re[5] * sc); o.w = pk2(re[6] * sc, re[7] * sc);
        *(u32x4*)(W1t + (size_t)(g * 256 + cp) * 1024 + k0) = o;
        o.x = pk2(im[0] * sc, im[1] * sc); o.y = pk2(im[2] * sc, im[3] * sc); o.z = pk2(im[4] * sc, im[5] * sc); o.w = pk2(im[6] * sc, im[7] * sc);
        *(u32x4*)(W1t + (size_t)(g * 256 + 128 + cp) * 1024 + k0) = o;
    }
    LDS_WAIT(); asm volatile("" ::: "memory");
}
DI void p0_prologue(const Frame& F, const Args& a) {
    LAS float* scr = (LAS float*)(F.lds + F.wave * 16384);
    const int gw = F.vcu * 8 + F.wave, NGW = F.G * 8, lane = F.lane;
    unsigned char* ws = F.ws;
    bf16_t* W1t = (bf16_t*)(ws + WS_W1T);
    constexpr int I_IN = 16 * 64, I_GATE = 16 * 96, I_KV = 16 * 32, I_BR = 8 * 32, I_OUT = 16 * 32, I_FOLD = 512;
    constexpr int NITEMS = I_FOLD + I_IN + I_GATE + I_KV + 3 * I_BR + I_OUT;
    for (int it = gw; it < NITEMS; it += NGW) {
        int r = it;
        if (r < I_FOLD) { fold_item(a.in[IN_WIN], W1t, scr, r, lane); continue; } r -= I_FOLD;
        if (r < I_IN) { tr_item(a.in[IN_WIN], 2560, 512, 2048, W1t, 1024, 1024, scr, r, lane); continue; } r -= I_IN;
        if (r < I_GATE) { tr_item(a.in[IN_WGATE], 3072, 0, 3072, W1t, 1024, 3072, scr, r, lane); continue; } r -= I_GATE;
        if (r < I_KV) { tr_item(a.in[IN_WMEMKV], 1024, 0, 1024, (bf16_t*)(ws + WS_WKVT), 1024, 0, scr, r, lane); continue; } r -= I_KV;
        if (r < I_BR) { tr_item(a.in[IN_WFO], 1024, 0, 1024, (bf16_t*)(ws + WS_WFOT), 512, 0, scr, r, lane); continue; } r -= I_BR;
        if (r < I_BR) { tr_item(a.in[IN_WNAO], 1024, 0, 1024, (bf16_t*)(ws + WS_WNAT), 512, 0, scr, r, lane); continue; } r -= I_BR;
        if (r < I_BR) { tr_item(a.in[IN_WMEMO], 1024, 0, 1024, (bf16_t*)(ws + WS_WMOT), 512, 0, scr, r, lane); continue; } r -= I_BR;
        tr_item(a.in[IN_WOUT], 1024, 0, 1024, (bf16_t*)(ws + WS_WOUTT), 1024, 0, scr, r, lane);
    }
    for (int m = gw; m < T; m += NGW) cvt_row_1024(a.in[IN_X] + (size_t)m * DM, (bf16_t*)(ws + WS_XB) + (size_t)m * DM, lane);
    for (int m = gw; m < NBATCH * MEML; m += NGW) cvt_row_1024(a.in[IN_MEM] + (size_t)m * DM, (bf16_t*)(ws + WS_MEMB) + (size_t)m * DM, lane);
    const int gt = F.vcu * 512 + F.tid, NGT = F.G * 512;
    { bf16_t* wr = (bf16_t*)(ws + WS_WRT);
      for (int i = gt; i < 80 * 1024; i += NGT) { const int r = i >> 10, k = i & 1023;
          const float v = r < 64 ? a.in[IN_WRE][k * 64 + r] : (r < 72 ? a.in[IN_WRG][k * 8 + (r - 64)] : 0.f);
          wr[i] = (bf16_t)(pk2(v, 0.f) & 0xffffu); } }
    { bf16_t* f = (bf16_t*)(ws + WS_F64);
      for (int i = gt; i < 128 * 128; i += NGT) { const int j = i & 7, ln = (i >> 3) & 63, nt = (i >> 9) & 7, ks = i >> 12;
          const int k = 32 * ks + 8 * (ln >> 4) + j, m = 16 * nt + (ln & 15), ri = k >> 6, n1 = k & 63, rip = m >> 6, k1 = m & 63;
          float sv, cv; sincospif((float)((n1 * k1) & 63) * (1.0f / 32.0f), &sv, &cv);
          const float v = (ri == rip) ? cv : (ri == 1 ? sv : -sv);
          f[i] = (bf16_t)(pk2(v * 0.125f, 0.f) & 0xffffu); } }
    { bf16_t* f = (bf16_t*)(ws + WS_C128);
      for (int i = gt; i < 256 * 128; i += NGT) { const int j = i & 7, ln = (i >> 3) & 63, nt = (i >> 9) & 7, ks = i >> 12;
          const int k = 32 * ks + 8 * (ln >> 4) + j, k2 = 16 * nt + (ln & 15), rip = k >> 7, n2 = k & 127;
          float sv, cv; sincospif((float)((n2 * k2) & 127) * (1.0f / 64.0f), &sv, &cv);
          f[i] = (bf16_t)(pk2((rip == 0 ? cv : sv) * 0.08838834764831845f, 0.f) & 0xffffu); } }
}
DI void p_expert_cvt(const Frame& F, const Args& a) {
    LAS float* scr = (LAS float*)(F.lds + F.wave * 16384);
    const int gw = F.vcu * 8 + F.wave, NGW = F.G * 8, lane = F.lane;
    bf16_t* wgu = (bf16_t*)(F.ws + WS_WGUT); bf16_t* wd = (bf16_t*)(F.ws + WS_WDT);
    for (int it = gw; it < NEXP * 768; it += NGW) {
        const int e = it / 768; int r = it % 768;
        if (r < 512) { const int up = r >> 8; r &= 255; const int kb = r >> 4, nb = r & 15, n0 = 32 * nb;
            const float* W = (up ? a.in[IN_WEU] : a.in[IN_WEG]) + (size_t)e * 1024 * 512;
            tr_tile(W, 512, n0, 64 * kb, wgu + (size_t)e * 1024 * 1024, 1024, (n0 >> 7) * 256 + up * 128 + (n0 & 127), scr, lane);
        } else { r -= 512; const int kb = r >> 5, nb = r & 31;
            tr_tile(a.in[IN_WED] + (size_t)e * 512 * 1024, 1024, 32 * nb, 64 * kb, wd + (size_t)e * 1024 * 512, 512, 32 * nb, scr, lane);
        }
    }
}

struct EpiP1 {
    static constexpr bool PERM = true;
    unsigned char* ws; const float* bgate;
    DI void operator()(Acc& acc, const GU& u, int wr, int wc, int fr, int fq) const {
        bf16_t* base; int ld; float sc = 1.f; const float* bias = nullptr;
        switch (u.p0) {
            case 0: base = (bf16_t*)(ws + WS_ZT) + (size_t)u.p1 * 256 * 8192 + (size_t)u.p2 * 256; ld = 8192; break;
            case 1: base = (bf16_t*)(ws + WS_Q) + (size_t)u.p1 * 256 * 512 + u.p2 * 256; ld = 512; sc = 0.125f; break;
            case 2: base = (bf16_t*)(ws + WS_K) + (size_t)u.p1 * 256 * 512 + u.p2 * 256; ld = 512; break;
            case 3: base = (bf16_t*)(ws + WS_VT) + (size_t)u.p1 * 256 * 8192 + (size_t)u.p2 * 256; ld = 8192; break;
            case 4: base = (bf16_t*)(ws + WS_QM) + (size_t)u.p1 * 256 * 512 + u.p2 * 256; ld = 512; sc = 0.08838834764831845f; break;
            case 5: base = (bf16_t*)(ws + WS_GATES) + (size_t)u.p1 * 256 * 3072 + u.p2 * 256; ld = 3072; bias = bgate + u.p2 * 256; break;
            case 6: base = (bf16_t*)(ws + WS_KVM) + (size_t)u.p1 * 256 * 512 + u.p2 * 256; ld = 512; break;
            default: base = (bf16_t*)(ws + WS_KVM + MiB) + (size_t)u.p1 * 256 * 256; ld = 256; break;
        }
        const int row0 = wr * 64 + fr, col0 = wc * 32 + 8 * fq;
        f32x4 bv[2][2];
#pragma unroll
        for (int bj = 0; bj < 2; ++bj)
#pragma unroll
            for (int n = 0; n < 2; ++n) bv[bj][n] = bias ? *(const f32x4*)(bias + col0 + bj * 128 + 4 * n) : (f32x4){0.f, 0.f, 0.f, 0.f};
#pragma unroll
        for (int ai = 0; ai < 2; ++ai)
#pragma unroll
            for (int m = 0; m < 4; ++m) { bf16_t* rowp = base + (size_t)(row0 + ai * 128 + m * 16) * ld + col0;
#pragma unroll
                for (int bj = 0; bj < 2; ++bj) { f32x4 v0 = acc[ai][bj][m][0], v1 = acc[ai][bj][m][1];
                    if (bias) {
                        v0 = v0 + bv[bj][0]; v1 = v1 + bv[bj][1];
#pragma unroll
                        for (int j = 0; j < 4; ++j) { v0[j] = fmaxf(fast_sigmoid(v0[j]), 9.5367431640625e-07f); v1[j] = fmaxf(fast_sigmoid(v1[j]), 9.5367431640625e-07f); }
                    } else { v0 = v0 * sc; v1 = v1 * sc; }
                    u32x4 w; w.x = pk2(v0[0], v0[1]); w.y = pk2(v0[2], v0[3]); w.z = pk2(v1[0], v1[1]); w.w = pk2(v1[2], v1[3]);
                    *(u32x4*)(rowp + bj * 128) = w;
                    acc[ai][bj][m][0] = (f32x4){0.f, 0.f, 0.f, 0.f}; acc[ai][bj][m][1] = (f32x4){0.f, 0.f, 0.f, 0.f}; } }
    }
};
struct SchedP1F {
    static constexpr bool GATHER = false;
    int K, G, c; const char* xb; const char* w1t;
    DI unsigned rowoffA(int r) const { return (unsigned)r * 2048u; }
    DI unsigned hstepA() const { return 128u * 2048u; }
    DI unsigned rowoffB(int r) const { return (unsigned)((r & 63) * 128 + (r >> 6)) * 2048u; }
    DI unsigned hstepB() const { return 2u * 2048u; }
    DI unsigned gatherA(const GU&, int) const { return 0u; }
    DI bool next(int i, GU& u) const {
        const int L = i * G + c; if (L >= 512) return false;
        int pm, pn; pg8::tile_order(L, 128, 4, pm, pn);
        const int b = pm >> 5, pp = pm & 31;
        u.A = w1t + (size_t)pn * 256 * 2048; u.B = xb + ((size_t)b * 8192 + 4 * pp) * 2048;
        u.p0 = 0; u.p1 = b * 4 + pn; u.p2 = pp; u.p3 = 0; return true;
    }
};
struct SchedP1 {
    static constexpr bool GATHER = false;
    int K, G, c; const char* xb; const char* w1t; const char* memb; const char* wkvt;
    DI unsigned rowoffA(int r) const { return (unsigned)r * 2048u; }
    DI unsigned hstepA() const { return 128u * 2048u; }
    DI unsigned rowoffB(int r) const { return (unsigned)r * 2048u; }
    DI unsigned hstepB() const { return 128u * 2048u; }
    DI unsigned gatherA(const GU&, int) const { return 0u; }
    DI bool next(int i, GU& u) const {
        const int L = i * G + c; u.p3 = 0;
        if (L < 2560) {
            int pm, pn; pg8::tile_order(L, 128, 20, pm, pn);
            const char* xt = xb + (size_t)pm * 256 * 2048;
            if (pn < 2)       { u.A = xt; u.B = w1t + (size_t)(1024 + 256 * pn) * 2048; u.p0 = 1; u.p1 = pm; u.p2 = pn; }
            else if (pn < 4)  { u.A = xt; u.B = w1t + (size_t)(1536 + 256 * (pn - 2)) * 2048; u.p0 = 2; u.p1 = pm; u.p2 = pn - 2; }
            else if (pn < 6)  { u.A = w1t + (size_t)(2048 + 256 * (pn - 4)) * 2048; u.B = xt; u.p0 = 3; u.p1 = (pm >> 5) * 2 + (pn - 4); u.p2 = pm & 31; }
            else if (pn < 8)  { u.A = xt; u.B = w1t + (size_t)(2560 + 256 * (pn - 6)) * 2048; u.p0 = 4; u.p1 = pm; u.p2 = pn - 6; }
            else              { u.A = xt; u.B = w1t + (size_t)(3072 + 256 * (pn - 8)) * 2048; u.p0 = 5; u.p1 = pm; u.p2 = pn - 8; }
            return true;
        }
        const int j = L - 2560; if (j >= 16) return false;
        if (j < 8) { const int pm = j >> 1, pn = j & 1; u.A = memb + (size_t)pm * 256 * 2048; u.B = wkvt + (size_t)pn * 256 * 2048; u.p0 = 6; u.p1 = pm; u.p2 = pn; }
        else { const int f = (j - 8) >> 2, b = (j - 8) & 3; u.A = wkvt + (size_t)(512 + 256 * f) * 2048; u.B = memb + (size_t)b * 256 * 2048; u.p0 = 7; u.p1 = b * 2 + f; u.p2 = 0; }
        return true;
    }
};

struct EpiMerge {
    static constexpr bool PERM = true;
    const bf16_t* gates; bf16_t* merged;
    DI void operator()(Acc& acc, const GU& u, int wr, int wc, int fr, int fq) const {
        const int seg = u.p0, pm = u.p1, pn = u.p2;
        const int row0 = pm * 256 + wr * 64 + fr, col0 = pn * 256 + wc * 32 + 8 * fq;
#pragma unroll
        for (int ai = 0; ai < 2; ++ai)
#pragma unroll
            for (int m = 0; m < 4; ++m) { const size_t r = (size_t)(row0 + ai * 128 + m * 16);
#pragma unroll
                for (int bj = 0; bj < 2; ++bj) {
                    const bf16_t* gp = gates + r * 3072 + seg * 1024 + col0 + bj * 128;
                    const u32x4 ga = *(const u32x4*)gp;
                    float g[8] = {bf_lo(ga.x), bf_hi(ga.x), bf_lo(ga.y), bf_hi(ga.y), bf_lo(ga.z), bf_hi(ga.z), bf_lo(ga.w), bf_hi(ga.w)};
                    if (seg < 2) {
                        const u32x4 gb = *(const u32x4*)(gp + 1024);
                        const float h[8] = {bf_lo(gb.x), bf_hi(gb.x), bf_lo(gb.y), bf_hi(gb.y), bf_lo(gb.z), bf_hi(gb.z), bf_lo(gb.w), bf_hi(gb.w)};
#pragma unroll
                        for (int j = 0; j < 8; ++j) g[j] = g[j] * __builtin_amdgcn_rcpf(h[j]);
                    }
                    f32x4 v0 = acc[ai][bj][m][0], v1 = acc[ai][bj][m][1];
#pragma unroll
                    for (int j = 0; j < 4; ++j) { v0[j] *= g[j]; v1[j] *= g[4 + j]; }
                    if (seg == 2) {
                        u32x4 w; w.x = pk2(v0[0], v0[1]); w.y = pk2(v0[2], v0[3]); w.z = pk2(v1[0], v1[1]); w.w = pk2(v1[2], v1[3]);
                        *(u32x4*)(merged + r * 1024 + col0 + bj * 128) = w;
                        v0 = (f32x4){0.f, 0.f, 0.f, 0.f}; v1 = v0;
                    }
                    acc[ai][bj][m][0] = v0; acc[ai][bj][m][1] = v1; } }
    }
};
struct SchedMerge {
    static constexpr bool GATHER = false;
    int K, G, c; const char* a0; const char* b0;
    DI unsigned rowoffA(int r) const { return (unsigned)r * 1024u; }
    DI unsigned hstepA() const { return 128u * 1024u; }
    DI unsigned rowoffB(int r) const { return (unsigned)r * 1024u; }
    DI unsigned hstepB() const { return 128u * 1024u; }
    DI unsigned gatherA(const GU&, int) const { return 0u; }
    DI bool next(int i, GU& u) const {
        const int tile = i / 3, seg = i - 3 * tile, L = tile * G + c; if (L >= 512) return false;
        int pm, pn; pg8::tile_order(L, 128, 4, pm, pn);
        u.A = a0 + (size_t)seg * (32 * MiB) + (size_t)pm * 256 * 1024; u.B = b0 + (size_t)seg * MiB + (size_t)pn * 256 * 1024; u.p0 = seg; u.p1 = pm; u.p2 = pn; u.p3 = 0; return true;
    }
};
static_assert(WS_ONA == WS_Y + 32 * MiB && WS_OMEM == WS_Y + 64 * MiB && WS_WNAT == WS_WFOT + MiB && WS_WMOT == WS_WFOT + 2 * MiB, "P4 segment strides");

struct EpiOut {
    static constexpr bool PERM = false;
    const float* x; float* v;
    DI void operator()(Acc& acc, const GU& u, int wr, int wc, int fr, int fq) const {
        const int row0 = u.p1 * 256 + wr * 64 + fr, col0 = u.p2 * 256 + wc * 32 + 4 * fq;
#pragma unroll
        for (int ai = 0; ai < 2; ++ai)
#pragma unroll
            for (int m = 0; m < 4; ++m) { const size_t off = (size_t)(row0 + ai * 128 + m * 16) * 1024 + col0;
#pragma unroll
                for (int bj = 0; bj < 2; ++bj)
#pragma unroll
                    for (int n = 0; n < 2; ++n) { const f32x4 xv = *(const f32x4*)(x + off + bj * 128 + n * 16);
                        *(f32x4*)(v + off + bj * 128 + n * 16) = xv * ALPHA + acc[ai][bj][m][n]; acc[ai][bj][m][n] = (f32x4){0.f, 0.f, 0.f, 0.f}; } }
    }
};
struct SchedOut {
    static constexpr bool GATHER = false;
    int K, G, c; const char* a; const char* b;
    DI unsigned rowoffA(int r) const { return (unsigned)r * 2048u; }
    DI unsigned hstepA() const { return 128u * 2048u; }
    DI unsigned rowoffB(int r) const { return (unsigned)r * 2048u; }
    DI unsigned hstepB() const { return 128u * 2048u; }
    DI unsigned gatherA(const GU&, int) const { return 0u; }
    DI bool next(int i, GU& u) const {
        const int L = i * G + c; if (L >= 512) return false;
        int pm, pn; pg8::tile_order(L, 128, 4, pm, pn);
        u.A = a + (size_t)pm * 256 * 2048; u.B = b + (size_t)pn * 256 * 2048; u.p0 = 0; u.p1 = pm; u.p2 = pn; u.p3 = 0; return true;
    }
};

DI void moe_tables(const Frame& F) {
    LAS int* tstart = (LAS int*)(F.lds + MISC_OFF + MS_TSTART); LAS int* cnt = (LAS int*)(F.lds + MISC_OFF + MS_CNT);
    LAS unsigned short* tile_e = (LAS unsigned short*)(F.lds + MISC_OFF + MS_TILEE);
    const unsigned* gcnt = (const unsigned*)(F.ws + WS_CTL) + CW_GCNT;
    __syncthreads();
    if (F.tid < 64) { int c = (int)__hip_atomic_load(gcnt + F.tid, __ATOMIC_RELAXED, __HIP_MEMORY_SCOPE_AGENT); c = c > LIST_CAP ? LIST_CAP : c; cnt[F.tid] = c; }
    __syncthreads();
    if (F.tid == 0) { int s = 0; for (int e = 0; e < 64; ++e) { tstart[e] = s; s += (cnt[e] + 255) >> 8; } tstart[64] = s; }
    __syncthreads();
    if (F.tid < 64) { const int e = F.tid; for (int t = tstart[e]; t < tstart[e + 1]; ++t) tile_e[t] = (unsigned short)e; }
    __syncthreads();
}
struct SchedMoeGU {
    static constexpr bool GATHER = true;
    int K, G, c; const char* h; const char* wgu; const int* list; LAS unsigned char* misc;
    DI unsigned rowoffA(int) const { return 0u; }
    DI unsigned hstepA() const { return 0u; }
    DI unsigned rowoffB(int r) const { return (unsigned)r * 2048u; }
    DI unsigned hstepB() const { return 128u * 2048u; }
    DI unsigned gatherA(const GU& u, int r) const {
        const LAS int* cnt = (const LAS int*)(misc + MS_CNT);
        const int slot = u.p1 * 256 + r; const int tok = slot < cnt[u.p0] ? list[(size_t)u.p0 * LIST_CAP + slot] : 0;
        return (unsigned)tok * 2048u;
    }
    DI bool next(int i, GU& u) const {
        const LAS int* tstart = (const LAS int*)(misc + MS_TSTART); const LAS unsigned short* tile_e = (const LAS unsigned short*)(misc + MS_TILEE);
        const int L = i * G + c, tau = L >> 2, pn = L & 3; if (tau >= tstart[64]) return false;
        const int e = tile_e[tau];
        u.A = h; u.B = wgu + ((size_t)e * 1024 + 256 * pn) * 2048; u.p0 = e; u.p1 = tau - tstart[e]; u.p2 = pn; u.p3 = tau; return true;
    }
};
struct EpiSwiGLU {
    static constexpr bool PERM = true;
    bf16_t* H;
    DI void operator()(Acc& acc, const GU& u, int wr, int wc, int fr, int fq) const {
        const int row0 = u.p3 * 256 + wr * 64 + fr, col0 = u.p2 * 128 + wc * 32 + 8 * fq;
#pragma unroll
        for (int ai = 0; ai < 2; ++ai)
#pragma unroll
            for (int m = 0; m < 4; ++m) {
                float o[8];
#pragma unroll
                for (int n = 0; n < 2; ++n)
#pragma unroll
                    for (int j = 0; j < 4; ++j) { const float g = acc[ai][0][m][n][j], up = acc[ai][1][m][n][j]; o[4 * n + j] = g * fast_sigmoid(g) * up; }
                u32x4 w; w.x = pk2(o[0], o[1]); w.y = pk2(o[2], o[3]); w.z = pk2(o[4], o[5]); w.w = pk2(o[6], o[7]);
                *(u32x4*)(H + (size_t)(row0 + ai * 128 + m * 16) * 512 + col0) = w;
#pragma unroll
                for (int bj = 0; bj < 2; ++bj)
#pragma unroll
                    for (int n = 0; n < 2; ++n) acc[ai][bj][m][n] = (f32x4){0.f, 0.f, 0.f, 0.f}; }
    }
};
struct SchedMoeD {
    static constexpr bool GATHER = false;
    int K, G, c; const char* H; const char* wd; LAS unsigned char* misc;
    DI unsigned rowoffA(int r) const { return (unsigned)r * 1024u; }
    DI unsigned hstepA() const { return 128u * 1024u; }
    DI unsigned rowoffB(int r) const { return (unsigned)r * 1024u; }
    DI unsigned hstepB() const { return 128u * 1024u; }
    DI unsigned gatherA(const GU&, int) const { return 0u; }
    DI bool next(int i, GU& u) const {
        const LAS int* tstart = (const LAS int*)(misc + MS_TSTART); const LAS unsigned short* tile_e = (const LAS unsigned short*)(misc + MS_TILEE);
        const int L = i * G + c, tau = L >> 2, pn = L & 3; if (tau >= tstart[64]) return false;
        const int e = tile_e[tau];
        u.A = H + (size_t)tau * 256 * 1024; u.B = wd + ((size_t)e * 1024 + 256 * pn) * 1024; u.p0 = e; u.p1 = 0; u.p2 = pn; u.p3 = tau; return true;
    }
};
struct EpiDown {
    static constexpr bool PERM = true;
    bf16_t* Y;
    DI void operator()(Acc& acc, const GU& u, int wr, int wc, int fr, int fq) const {
        const int row0 = u.p3 * 256 + wr * 64 + fr, col0 = u.p2 * 256 + wc * 32 + 8 * fq;
#pragma unroll
        for (int ai = 0; ai < 2; ++ai)
#pragma unroll
            for (int m = 0; m < 4; ++m) { bf16_t* rowp = Y + (size_t)(row0 + ai * 128 + m * 16) * 1024 + col0;
#pragma unroll
                for (int bj = 0; bj < 2; ++bj) { const f32x4 v0 = acc[ai][bj][m][0], v1 = acc[ai][bj][m][1];
                    u32x4 w; w.x = pk2(v0[0], v0[1]); w.y = pk2(v0[2], v0[3]); w.z = pk2(v1[0], v1[1]); w.w = pk2(v1[2], v1[3]);
                    *(u32x4*)(rowp + bj * 128) = w;
                    acc[ai][bj][m][0] = (f32x4){0.f, 0.f, 0.f, 0.f}; acc[ai][bj][m][1] = (f32x4){0.f, 0.f, 0.f, 0.f}; } }
    }
};

#define MFMA16(a, b, c) __builtin_amdgcn_mfma_f32_16x16x32_bf16((a), (b), (c), 0, 0, 0)
DI void fft1_item(const bf16_t* zt, bf16_t* t1, const LAS unsigned char* fb, int item, int lane) {
    const int n2h = item & 1, c = (item >> 1) & 127, g = (item >> 8) & 3, b = item >> 10;
    const int fr = lane & 15, fq = lane >> 4, n2_0 = 64 * n2h;
#pragma unroll 1
    for (int a2 = 0; a2 < 2; ++a2) {
        f32x4 acc[2][8];
#pragma unroll
        for (int mt = 0; mt < 2; ++mt)
#pragma unroll
            for (int nt = 0; nt < 8; ++nt) acc[mt][nt] = (f32x4){0.f, 0.f, 0.f, 0.f};
        bf16x8 a[4][2];
#pragma unroll
        for (int ks = 0; ks < 4; ++ks) { const int ri = ks >> 1, n1_0 = 32 * (ks & 1) + 8 * fq;
            const bf16_t* rowb = zt + (size_t)(b * 1024 + g * 256 + ri * 128 + c) * 8192 + n1_0;
#pragma unroll
            for (int mt = 0; mt < 2; ++mt) { const int n2 = n2_0 + 32 * a2 + 8 * (fr >> 2) + 4 * mt + (fr & 3);
                a[ks][mt] = *(const bf16x8*)(rowb + n2 * 64); } }
#pragma unroll
        for (int ks = 0; ks < 4; ++ks)
#pragma unroll
            for (int nt = 0; nt < 8; ++nt) { const bf16x8 bf = *(const LAS bf16x8*)(fb + ((ks * 8 + nt) * 64 + lane) * 16);
#pragma unroll
                for (int mt = 0; mt < 2; ++mt) acc[mt][nt] = MFMA16(a[ks][mt], bf, acc[mt][nt]);
                if (nt == 7) asm volatile("" ::: "memory"); }
#pragma unroll
        for (int ntl = 0; ntl < 4; ++ntl) { const int k1 = 16 * ntl + fr; float ore[8], oim[8];
#pragma unroll
            for (int e = 0; e < 8; ++e) { const int n2 = n2_0 + 32 * a2 + 8 * fq + e;
                const float re = acc[e >> 2][ntl][e & 3], im = acc[e >> 2][ntl + 4][e & 3];
                const float ang = (float)((n2 * k1) & 8191) * (1.0f / 8192.0f);
                const float cs = __builtin_amdgcn_cosf(ang), sn = __builtin_amdgcn_sinf(ang);
                ore[e] = re * cs + im * sn; oim[e] = im * cs - re * sn; }
            bf16_t* o = t1 + ((size_t)(((b * 4 + g) * 128 + c) * 2) * 64 + k1) * 128 + n2_0 + 32 * a2 + 8 * fq;
            u32x4 w; w.x = pk2(ore[0], ore[1]); w.y = pk2(ore[2], ore[3]); w.z = pk2(ore[4], ore[5]); w.w = pk2(ore[6], ore[7]);
            *(u32x4*)o = w;
            w.x = pk2(oim[0], oim[1]); w.y = pk2(oim[2], oim[3]); w.z = pk2(oim[4], oim[5]); w.w = pk2(oim[6], oim[7]);
            *(u32x4*)(o + 64 * 128) = w; }
    }
}
DI void fft2_item(const bf16_t* t1, bf16_t* y, const LAS unsigned char* cb, int item, int lane) {
    const int chh = item & 1, k1 = (item >> 1) & 63, g = (item >> 7) & 3, b = item >> 9;
    const int fr = lane & 15, fq = lane >> 4;
#pragma unroll 1
    for (int a2 = 0; a2 < 2; ++a2) {
        f32x4 acc[2][8];
#pragma unroll
        for (int mt = 0; mt < 2; ++mt)
#pragma unroll
            for (int nt = 0; nt < 8; ++nt) acc[mt][nt] = (f32x4){0.f, 0.f, 0.f, 0.f};
#pragma unroll
        for (int kh = 0; kh < 2; ++kh) {
            bf16x8 a[4][2];
#pragma unroll
            for (int kq = 0; kq < 4; ++kq) { const int n2_0 = 32 * kq + 8 * fq;
#pragma unroll
                for (int mt = 0; mt < 2; ++mt) { const int c = 64 * chh + 32 * a2 + 8 * (fr >> 2) + 4 * mt + (fr & 3);
                    a[kq][mt] = *(const bf16x8*)(t1 + ((size_t)((((b * 4 + g) * 128 + c) * 2 + kh) * 64 + k1)) * 128 + n2_0); } }
#pragma unroll
            for (int kq = 0; kq < 4; ++kq)
#pragma unroll
                for (int nt = 0; nt < 8; ++nt) { const bf16x8 bf = *(const LAS bf16x8*)(cb + (((kh * 4 + kq) * 8 + nt) * 64 + lane) * 16);
#pragma unroll
                    for (int mt = 0; mt < 2; ++mt) acc[mt][nt] = MFMA16(a[kq][mt], bf, acc[mt][nt]);
                    if (nt == 7) asm volatile("" ::: "memory"); }
        }
#pragma unroll
        for (int nt = 0; nt < 8; ++nt) { const int k2 = 16 * nt + fr; const size_t tok = (size_t)b * 8192 + k1 + 64 * k2;
            const f32x4 v0 = acc[0][nt], v1 = acc[1][nt];
            u32x4 w; w.x = pk2(v0[0], v0[1]); w.y = pk2(v0[2], v0[3]); w.z = pk2(v1[0], v1[1]); w.w = pk2(v1[2], v1[3]);
            *(u32x4*)(y + tok * 512 + g * 128 + 64 * chh + 32 * a2 + 8 * fq) = w; }
    }
}

DI void na_item(const bf16_t* q, const bf16_t* k, const bf16_t* vt, bf16_t* o, const LAS float* rpbl, int item, int lane) {
    const int jb = item & 3, r = (item >> 2) & 127, h = (item >> 9) & 7, b = item >> 12;
    const int fr = lane & 15, fq = lane >> 4;
    const int rs = min(max(r - 4, 0), 120);
    const int w0 = jb == 0 ? 0 : (jb == 1 ? 8 : (jb == 2 ? 24 : 32));
    const size_t tokq = (size_t)b * 8192 + r * 64 + 16 * jb + fr;
    bf16x8 qf[2];
#pragma unroll
    for (int ks = 0; ks < 2; ++ks) qf[ks] = *(const bf16x8*)(q + tokq * 512 + h * 64 + 32 * ks + 8 * fq);
    f32x4 s[8][2];
#pragma unroll
    for (int i = 0; i < 8; ++i)
#pragma unroll
        for (int ch = 0; ch < 2; ++ch) { const size_t tk = (size_t)b * 8192 + (rs + i) * 64 + w0 + 16 * ch + fr;
            const bf16x8 k0 = *(const bf16x8*)(k + tk * 512 + h * 64 + 8 * fq), k1 = *(const bf16x8*)(k + tk * 512 + h * 64 + 32 + 8 * fq);
            f32x4 z = (f32x4){0.f, 0.f, 0.f, 0.f};
            z = MFMA16(k0, qf[0], z); s[i][ch] = MFMA16(k1, qf[1], z); }
    const int c = 16 * jb + fr, cs = min(max(c - 8, 0), 48);
    float mx = -1e30f;
#pragma unroll
    for (int i = 0; i < 8; ++i) { const LAS float* brow = rpbl + h * 480 + (rs + i - r + 7) * 32;
#pragma unroll
        for (int ch = 0; ch < 2; ++ch)
#pragma unroll
            for (int rr = 0; rr < 4; ++rr) { const int kc = w0 + 16 * ch + 4 * fq + rr; const bool valid = (kc >= cs) && (kc < cs + 16);
                const int dc = valid ? (kc - c + 15) : 0;
                const float v = valid ? s[i][ch][rr] + brow[dc] : -1e30f; s[i][ch][rr] = v; mx = fmaxf(mx, v); } }
    mx = fmaxf(mx, __shfl_xor(mx, 16)); mx = fmaxf(mx, __shfl_xor(mx, 32));
    float l = 0.f;
#pragma unroll
    for (int i = 0; i < 8; ++i)
#pragma unroll
        for (int ch = 0; ch < 2; ++ch)
#pragma unroll
            for (int rr = 0; rr < 4; ++rr) { const float p = __builtin_amdgcn_exp2f((s[i][ch][rr] - mx) * 1.4426950408889634f); s[i][ch][rr] = p; l += p; }
    l += __shfl_xor(l, 16); l += __shfl_xor(l, 32);
    const float inv = 1.0f / l;
    f32x4 oacc[4];
#pragma unroll
    for (int dt = 0; dt < 4; ++dt) oacc[dt] = (f32x4){0.f, 0.f, 0.f, 0.f};
#pragma unroll
    for (int i = 0; i < 8; ++i) {
        u32x4 pw; pw.x = pk2(s[i][0][0], s[i][0][1]); pw.y = pk2(s[i][0][2], s[i][0][3]); pw.z = pk2(s[i][1][0], s[i][1][1]); pw.w = pk2(s[i][1][2], s[i][1][3]);
        const bf16x8 pf = __builtin_bit_cast(bf16x8, pw);
#pragma unroll
        for (int dt = 0; dt < 4; ++dt) { const bf16_t* vb = vt + (size_t)(b * 512 + h * 64 + 16 * dt + fr) * 8192 + (rs + i) * 64 + w0 + 4 * fq;
            const u32x2 lo = *(const u32x2*)vb, hi = *(const u32x2*)(vb + 16);
            u32x4 vw; vw.x = lo.x; vw.y = lo.y; vw.z = hi.x; vw.w = hi.y;
            oacc[dt] = MFMA16(__builtin_bit_cast(bf16x8, vw), pf, oacc[dt]); } }
#pragma unroll
    for (int dt = 0; dt < 4; ++dt) { u32x2 w; w.x = pk2(oacc[dt][0] * inv, oacc[dt][1] * inv); w.y = pk2(oacc[dt][2] * inv, oacc[dt][3] * inv);
        *(u32x2*)(o + tokq * 512 + h * 64 + 16 * dt + 4 * fq) = w; }
}
DI void mem_item(const bf16_t* qm, const bf16_t* km, const bf16_t* vtm, bf16_t* o, int item, int lane) {
    const int qb = item & 511, h = (item >> 9) & 3, b = item >> 11;
    const int fr = lane & 15, fq = lane >> 4;
    const size_t tokq = (size_t)b * 8192 + 16 * qb + fr;
    bf16x8 qf[4];
#pragma unroll
    for (int ks = 0; ks < 4; ++ks) qf[ks] = *(const bf16x8*)(qm + tokq * 512 + h * 128 + 32 * ks + 8 * fq);
    f32x4 s[16];
#pragma unroll
    for (int kt = 0; kt < 16; ++kt) { const bf16_t* kb = km + (size_t)(b * 256 + 16 * kt + fr) * 512 + h * 128 + 8 * fq;
        f32x4 z = (f32x4){0.f, 0.f, 0.f, 0.f};
#pragma unroll
        for (int ks = 0; ks < 4; ++ks) z = MFMA16(*(const bf16x8*)(kb + 32 * ks), qf[ks], z);
        s[kt] = z; }
    float mx = -1e30f;
#pragma unroll
    for (int kt = 0; kt < 16; ++kt)
#pragma unroll
        for (int rr = 0; rr < 4; ++rr) mx = fmaxf(mx, s[kt][rr]);
    mx = fmaxf(mx, __shfl_xor(mx, 16)); mx = fmaxf(mx, __shfl_xor(mx, 32));
    float l = 0.f;
#pragma unroll
    for (int kt = 0; kt < 16; ++kt)
#pragma unroll
        for (int rr = 0; rr < 4; ++rr) { const float p = __builtin_amdgcn_exp2f((s[kt][rr] - mx) * 1.4426950408889634f); s[kt][rr] = p; l += p; }
    l += __shfl_xor(l, 16); l += __shfl_xor(l, 32);
    const float inv = 1.0f / l;
    f32x4 oacc[8];
#pragma unroll
    for (int dt = 0; dt < 8; ++dt) oacc[dt] = (f32x4){0.f, 0.f, 0.f, 0.f};
#pragma unroll
    for (int u = 0; u < 8; ++u) {
        u32x4 pw; pw.x = pk2(s[2 * u][0], s[2 * u][1]); pw.y = pk2(s[2 * u][2], s[2 * u][3]); pw.z = pk2(s[2 * u + 1][0], s[2 * u + 1][1]); pw.w = pk2(s[2 * u + 1][2], s[2 * u + 1][3]);
        const bf16x8 pf = __builtin_bit_cast(bf16x8, pw);
#pragma unroll
        for (int dt = 0; dt < 8; ++dt) { const bf16_t* vb = vtm + (size_t)(b * 512 + h * 128 + 16 * dt + fr) * 256 + 32 * u + 4 * fq;
            const u32x2 lo = *(const u32x2*)vb, hi = *(const u32x2*)(vb + 16);
            u32x4 vw; vw.x = lo.x; vw.y = lo.y; vw.z = hi.x; vw.w = hi.y;
            oacc[dt] = MFMA16(__builtin_bit_cast(bf16x8, vw), pf, oacc[dt]); } }
#pragma unroll
    for (int dt = 0; dt < 8; ++dt) { u32x2 w; w.x = pk2(oacc[dt][0] * inv, oacc[dt][1] * inv); w.y = pk2(oacc[dt][2] * inv, oacc[dt][3] * inv);
        *(u32x2*)(o + tokq * 512 + h * 128 + 16 * dt + 4 * fq) = w; }
}

DI void p6_ln_router(const Frame& F, const Args& a) {
    unsigned char* ws = F.ws; const int lane = F.lane, w = F.wave, fr = lane & 15, fq = lane >> 4;
    const float* v = (const float*)(ws + WS_V); bf16_t* h = (bf16_t*)(ws + WS_H); const bf16_t* wrt = (const bf16_t*)(ws + WS_WRT);
    unsigned* gcnt = (unsigned*)(ws + WS_CTL) + CW_GCNT; int* list = (int*)(ws + WS_LIST); unsigned* rec = (unsigned*)(ws + WS_REC);
    LAS float* lg = (LAS float*)(F.lds + w * 5120);
    LAS int* hist = (LAS int*)(F.lds + MISC_OFF + MS_HIST); LAS int* base = (LAS int*)(F.lds + MISC_OFF + MS_BASE);
    const float* g1 = a.in[IN_LN1G]; const float* b1 = a.in[IN_LN1B];
    f32x4 gv[4], bv[4];
#pragma unroll
    for (int j = 0; j < 4; ++j) { gv[j] = *(const f32x4*)(g1 + 4 * lane + 256 * j); bv[j] = *(const f32x4*)(b1 + 4 * lane + 256 * j); }
    for (int chunk = F.vcu; chunk < T / 128; chunk += F.G) {
        const int tok0 = chunk * 128 + 16 * w;
        if (F.tid < 64) hist[F.tid] = 0;
        for (int rr = 0; rr < 16; ++rr) { const size_t row = (size_t)(tok0 + rr);
            f32x4 x[4]; float s = 0.f;
#pragma unroll
            for (int j = 0; j < 4; ++j) { x[j] = *(const f32x4*)(v + row * 1024 + 4 * lane + 256 * j); s += (x[j][0] + x[j][1]) + (x[j][2] + x[j][3]); }
            const float mean = wave_sum(s) * (1.0f / 1024.0f); float s2 = 0.f;
#pragma unroll
            for (int j = 0; j < 4; ++j) { x[j] = x[j] - mean; s2 += (x[j][0] * x[j][0] + x[j][1] * x[j][1]) + (x[j][2] * x[j][2] + x[j][3] * x[j][3]); }
            const float rstd = 1.0f / sqrtf(wave_sum(s2) * (1.0f / 1024.0f) + LN_EPS);
#pragma unroll
            for (int j = 0; j < 4; ++j) { const f32x4 y = x[j] * rstd * gv[j] + bv[j]; u32x2 o; o.x = pk2(y[0], y[1]); o.y = pk2(y[2], y[3]);
                *(u32x2*)(h + row * 1024 + 4 * lane + 256 * j) = o; } }
        __syncthreads();
        f32x4 acc[5];
#pragma unroll
        for (int mt = 0; mt < 5; ++mt) acc[mt] = (f32x4){0.f, 0.f, 0.f, 0.f};
        const bf16_t* hb = h + (size_t)(tok0 + fr) * 1024 + 8 * fq; const bf16_t* wb = wrt + (size_t)fr * 1024 + 8 * fq;
#pragma unroll 4
        for (int ks = 0; ks < 32; ++ks) { const bf16x8 bfr = *(const bf16x8*)(hb + 32 * ks);
#pragma unroll
            for (int mt = 0; mt < 5; ++mt) acc[mt] = MFMA16(*(const bf16x8*)(wb + (size_t)mt * 16 * 1024 + 32 * ks), bfr, acc[mt]); }
#pragma unroll
        for (int mt = 0; mt < 5; ++mt)
#pragma unroll
            for (int rr = 0; rr < 4; ++rr) lg[fr * 80 + 16 * mt + 4 * fq + rr] = acc[mt][rr];
        LDS_WAIT(); asm volatile("" ::: "memory");
        int e1 = 0, e2 = 0, l1 = 0, l2 = 0; float w1 = 0.f, w2 = 0.f;
        if (lane < 16) {
            const LAS float* L = lg + lane * 80;
            float gl[8]; int gi = 0; float gm;
#pragma unroll
            for (int j = 0; j < 8; ++j) gl[j] = L[64 + j] + a.in[IN_BRG][j];
            gm = gl[0];
#pragma unroll
            for (int j = 1; j < 8; ++j) if (gl[j] > gm) { gm = gl[j]; gi = j; }
            float se = 0.f;
#pragma unroll
            for (int j = 0; j < 8; ++j) se += __expf(gl[j] - gm);
            const float pg = 1.0f / se;
            float el[8];
#pragma unroll
            for (int j = 0; j < 8; ++j) el[j] = L[gi * 8 + j] + a.in[IN_BRE][gi * 8 + j];
            int i1 = 0; float v1 = el[0];
#pragma unroll
            for (int j = 1; j < 8; ++j) if (el[j] > v1) { v1 = el[j]; i1 = j; }
            int i2 = -1; float v2 = -3.0e38f;
#pragma unroll
            for (int j = 0; j < 8; ++j) if (j != i1 && el[j] > v2) { v2 = el[j]; i2 = j; }
            const float t = __expf(v2 - v1); const float p1 = 1.0f / (1.0f + t);
            w1 = p1 * pg; w2 = (t * p1) * pg; e1 = gi * 8 + i1; e2 = gi * 8 + i2;
            l1 = __hip_atomic_fetch_add(&hist[e1], 1, __ATOMIC_RELAXED, __HIP_MEMORY_SCOPE_WORKGROUP); l2 = __hip_atomic_fetch_add(&hist[e2], 1, __ATOMIC_RELAXED, __HIP_MEMORY_SCOPE_WORKGROUP);
        }
        __syncthreads();
        if (F.tid < 64) { const int c = hist[F.tid]; base[F.tid] = c > 0 ? (int)atomicAdd(gcnt + F.tid, (unsigned)c) : 0; }
        __syncthreads();
        if (lane < 16) { const int tok = tok0 + lane; const int s1 = base[e1] + l1, s2 = base[e2] + l2;
            if (s1 < LIST_CAP) list[(size_t)e1 * LIST_CAP + s1] = tok;
            if (s2 < LIST_CAP) list[(size_t)e2 * LIST_CAP + s2] = tok;
            u32x4 r0; r0.x = (unsigned)e1; r0.y = (unsigned)s1; r0.z = (unsigned)e2; r0.w = (unsigned)s2;
            *(u32x4*)(rec + (size_t)tok * 8) = r0;
            u32x2 r1; r1.x = __float_as_uint(w1); r1.y = __float_as_uint(w2); *(u32x2*)(rec + (size_t)tok * 8 + 4) = r1; }
        __syncthreads();
    }
}

DI void p9_combine(const Frame& F, const Args& a) {
    unsigned char* ws = F.ws; const int lane = F.lane;
    const bf16_t* h = (const bf16_t*)(ws + WS_H); const bf16_t* yb = (const bf16_t*)(ws + WS_YB); const unsigned* rec = (const unsigned*)(ws + WS_REC);
    const LAS int* tstart = (const LAS int*)(F.lds + MISC_OFF + MS_TSTART);
    f32x4 gv[4], bv[4];
#pragma unroll
    for (int j = 0; j < 4; ++j) { gv[j] = *(const f32x4*)(a.in[IN_LN2G] + 4 * lane + 256 * j); bv[j] = *(const f32x4*)(a.in[IN_LN2B] + 4 * lane + 256 * j); }
    const int gw = F.vcu * 8 + F.wave, NGW = F.G * 8;
    for (int t = gw; t < T; t += NGW) {
        const u32x4 r0 = *(const u32x4*)(rec + (size_t)t * 8); const u32x2 r1 = *(const u32x2*)(rec + (size_t)t * 8 + 4);
        const size_t row1 = (size_t)tstart[r0.x] * 256 + r0.y, row2 = (size_t)tstart[r0.z] * 256 + r0.w;
        const float w1 = __uint_as_float(r1.x), w2 = __uint_as_float(r1.y);
        f32x4 x[4]; float s = 0.f;
#pragma unroll
        for (int j = 0; j < 4; ++j) { const int col = 4 * lane + 256 * j;
            const u32x2 hv = *(const u32x2*)(h + (size_t)t * 1024 + col), y1 = *(const u32x2*)(yb + row1 * 1024 + col), y2 = *(const u32x2*)(yb + row2 * 1024 + col);
            x[j][0] = ALPHA * bf_lo(hv.x) + w1 * bf_lo(y1.x) + w2 * bf_lo(y2.x); x[j][1] = ALPHA * bf_hi(hv.x) + w1 * bf_hi(y1.x) + w2 * bf_hi(y2.x);
            x[j][2] = ALPHA * bf_lo(hv.y) + w1 * bf_lo(y1.y) + w2 * bf_lo(y2.y); x[j][3] = ALPHA * bf_hi(hv.y) + w1 * bf_hi(y1.y) + w2 * bf_hi(y2.y);
            s += (x[j][0] + x[j][1]) + (x[j][2] + x[j][3]); }
        const float mean = wave_sum(s) * (1.0f / 1024.0f); float s2 = 0.f;
#pragma unroll
        for (int j = 0; j < 4; ++j) { x[j] = x[j] - mean; s2 += (x[j][0] * x[j][0] + x[j][1] * x[j][1]) + (x[j][2] * x[j][2] + x[j][3] * x[j][3]); }
        const float rstd = 1.0f / sqrtf(wave_sum(s2) * (1.0f / 1024.0f) + LN_EPS);
#pragma unroll
        for (int j = 0; j < 4; ++j) *(f32x4*)(a.out + (size_t)t * 1024 + 4 * lane + 256 * j) = x[j] * rstd * gv[j] + bv[j];
    }
}

constexpr int N_PHASES = 11;
__global__ void __launch_bounds__(512, 2) mk_fwd(Args args) {
    extern __shared__ __attribute__((aligned(16))) unsigned char lds_raw[];
    Frame F;
    F.lds = (LAS unsigned char*)lds_raw;
    F.tid = threadIdx.x; F.lane = F.tid & 63; F.wave = __builtin_amdgcn_readfirstlane(F.tid >> 6);
    F.G = gridDim.x; { const int bx = blockIdx.x; F.vcu = (F.G % 8 == 0) ? (bx % 8) * (F.G / 8) + bx / 8 : bx; }
    F.ws = args.ws;
    unsigned char* ws = args.ws;
    for (int u = F.tid; u < (LDS_BYTES - MISC_OFF) / 4; u += 512) ((LAS unsigned*)(F.lds + MISC_OFF))[u] = 0u;
    __syncthreads();
    const int lo = args.ph_lo, hi = args.ph_hi;
    XcdBarrier bar; bar.bar = (unsigned*)(ws + WS_CTL) + CW_BAR; bar.x = 0; bar.st = nullptr;
    if (hi - lo > 1) bar = xcd_barrier_post((unsigned*)(ws + WS_CTL) + CW_BAR, (volatile LAS unsigned*)(F.lds + MISC_OFF + MS_BAR));
#ifndef PH_MASK
#define PH_MASK 0xffff
#endif
#define IN(k) (((PH_MASK >> (k)) & 1) && lo <= (k) && (k) < hi)
#define SEAM(k) do { if (IN(k) && IN((k) + 1)) xcd_barrier(bar); } while (0)
    const int cid = (int)blockIdx.x;

    if (IN(0)) { p0_prologue(F, args); }
    SEAM(0);
    if (IN(1)) {
        { SchedP1F S{1024, F.G, cid, (const char*)(ws + WS_XB), (const char*)(ws + WS_W1T)}; EpiP1 E{ws, args.in[IN_BGATE]};
          pg8::gemm_phase<EpiP1, SchedP1F>(F.lds, S, E); }
        { SchedP1 S{1024, F.G, cid, (const char*)(ws + WS_XB), (const char*)(ws + WS_W1T), (const char*)(ws + WS_MEMB), (const char*)(ws + WS_WKVT)}; EpiP1 E{ws, args.in[IN_BGATE]};
          pg8::gemm_phase<EpiP1, SchedP1>(F.lds, S, E); }
    }
    SEAM(1);
    if (IN(2)) {
        LAS float* rpbl = (LAS float*)F.lds;
        for (int i = F.tid; i < 8 * 15 * 32; i += 512) { const int dc = i & 31, dr = (i >> 5) % 15, hh = i / 480; rpbl[i] = dc < 31 ? args.in[IN_RPB][(hh * 15 + dr) * 31 + dc] : 0.f; }
        LAS unsigned char* fb = F.lds + 16384;
        for (int i = F.tid; i < 2048; i += 512) *(LAS u32x4*)(fb + i * 16) = *(const u32x4*)(ws + WS_F64 + (size_t)i * 16);
        __syncthreads();
        const int gw = F.vcu * 8 + F.wave, NGW = F.G * 8;
        for (int it = gw; it < 4096; it += NGW) fft1_item((const bf16_t*)(ws + WS_ZT), (bf16_t*)(ws + WS_T1), fb, it, F.lane);
        for (int it = gw; it < 16384; it += NGW) na_item((const bf16_t*)(ws + WS_Q), (const bf16_t*)(ws + WS_K), (const bf16_t*)(ws + WS_VT), (bf16_t*)(ws + WS_ONA), rpbl, it, F.lane);
        for (int it = gw; it < 8192; it += NGW) mem_item((const bf16_t*)(ws + WS_QM), (const bf16_t*)(ws + WS_KVM), (const bf16_t*)(ws + WS_KVM + MiB), (bf16_t*)(ws + WS_OMEM), it, F.lane);
    }
    SEAM(2);
    if (IN(3)) {
        LAS unsigned char* cb = F.lds;
        for (int i = F.tid; i < 4096; i += 512) *(LAS u32x4*)(cb + i * 16) = *(const u32x4*)(ws + WS_C128 + (size_t)i * 16);
        __syncthreads();
        const int gw = F.vcu * 8 + F.wave, NGW = F.G * 8;
        for (int it = gw; it < 2048; it += NGW) fft2_item((const bf16_t*)(ws + WS_T1), (bf16_t*)(ws + WS_Y), cb, it, F.lane);
        __syncthreads();
    }
    SEAM(3);
    if (IN(4)) {
        SchedMerge S{512, F.G, cid, (const char*)(ws + WS_Y), (const char*)(ws + WS_WFOT)};
        EpiMerge E{(const bf16_t*)(ws + WS_GATES), (bf16_t*)(ws + WS_MERGED)};
        pg8::gemm_phase<EpiMerge, SchedMerge>(F.lds, S, E);
    }
    SEAM(4);
    if (IN(5)) { p_expert_cvt(F, args); }
    SEAM(5);
    if (IN(6)) {
        SchedOut S{1024, F.G, cid, (const char*)(ws + WS_MERGED), (const char*)(ws + WS_WOUTT)}; EpiOut E{args.in[IN_X], (float*)(ws + WS_V)};
        pg8::gemm_phase<EpiOut, SchedOut>(F.lds, S, E);
    }
    SEAM(6);
    if (IN(7)) { p6_ln_router(F, args); }
    SEAM(7);
    if (IN(8)) {
        moe_tables(F);
        SchedMoeGU S{1024, F.G, cid, (const char*)(ws + WS_H), (const char*)(ws + WS_WGUT), (const int*)(ws + WS_LIST), F.lds + MISC_OFF}; EpiSwiGLU E{(bf16_t*)(ws + WS_HMOE)};
        pg8::gemm_phase<EpiSwiGLU, SchedMoeGU>(F.lds, S, E);
    }
    SEAM(8);
    if (IN(9)) {
        moe_tables(F);
        SchedMoeD S{512, F.G, cid, (const char*)(ws + WS_HMOE), (const char*)(ws + WS_WDT), F.lds + MISC_OFF}; EpiDown E{(bf16_t*)(ws + WS_YB)};
        pg8::gemm_phase<EpiDown, SchedMoeD>(F.lds, S, E);
    }
    SEAM(9);
    if (IN(10)) { moe_tables(F); p9_combine(F, args); }
#undef IN
#undef SEAM
}

#ifndef MK_PER_PHASE
#define MK_PER_PHASE 0
#endif
extern "C" void kernel_launch(void* const* d_in, const int* in_sizes, int n_in, void* d_out, int out_size, void* d_ws, size_t ws_size, hipStream_t stream) {
    static int grid = 0;
    if (grid == 0) {
        if (n_in != 22 || in_sizes[0] != T * DM || out_size != T * DM || ws_size < WS_END) {
            fprintf(stderr, "kernel_launch: unexpected problem (n_in %d, in0 %d, out %d, ws %zu < %zu); nothing launched\n", n_in, n_in > 0 ? in_sizes[0] : -1, out_size, ws_size, (size_t)WS_END); grid = -1; return; }
        int dev = 0, cus = 0, per_cu = 0;
        if (hipGetDevice(&dev) != hipSuccess || hipDeviceGetAttribute(&cus, hipDeviceAttributeMultiprocessorCount, dev) != hipSuccess) { grid = -1; return; }
        if (hipFuncSetAttribute((const void*)mk_fwd, hipFuncAttributeMaxDynamicSharedMemorySize, LDS_BYTES) != hipSuccess) { fprintf(stderr, "kernel_launch: hipFuncSetAttribute failed\n"); grid = -1; return; }
        if (hipOccupancyMaxActiveBlocksPerMultiprocessor(&per_cu, (const void*)mk_fwd, 512, LDS_BYTES) != hipSuccess || per_cu < 1)
            fprintf(stderr, "kernel_launch: occupancy query reports %d workgroups per CU\n", per_cu);
        (void)hipGetLastError();
        grid = cus;
    }
    if (grid < 0) return;
    if (hipMemsetAsync((char*)d_ws + WS_CTL, 0, CTL_ZERO_BYTES, stream) != hipSuccess) return;
    Args a{};
    for (int i = 0; i < 22; ++i) a.in[i] = (const float*)d_in[i];
    a.out = (float*)d_out; a.ws = (unsigned char*)d_ws;
#if MK_PER_PHASE
    for (int p = 0; p < N_PHASES; ++p) { a.ph_lo = p; a.ph_hi = p + 1; hipLaunchKernelGGL(mk_fwd, dim3(grid), dim3(512), LDS_BYTES, stream, a); }
#else
    a.ph_lo = 0; a.ph_hi = N_PHASES; hipLaunchKernelGGL(mk_fwd, dim3(grid), dim3(512), LDS_BYTES, stream, a);
#endif
}
```

```cpp
#include <hip/hip_runtime.h>
#include <cstdio>
#include <cstdint>

#define DI __device__ __forceinline__
#define LAS __attribute__((address_space(3)))
#define GAS __attribute__((address_space(1)))
typedef unsigned short bf16_t;
typedef short bf16x8 __attribute__((ext_vector_type(8)));
typedef float f32x4 __attribute__((ext_vector_type(4)));
typedef float f32x2 __attribute__((ext_vector_type(2)));
typedef unsigned u32x4 __attribute__((ext_vector_type(4)));
typedef unsigned u32x2 __attribute__((ext_vector_type(2)));

constexpr int T = 32768, DM = 1024, NBATCH = 4, SEQ = 8192, MEML = 256;
constexpr int NEXP = 64, DEXP = 512;
constexpr float ALPHA = 1.189207115002721f;
constexpr float LN_EPS = 1e-5f;
constexpr int LIST_CAP = 32768;

constexpr size_t MiB = 1u << 20;
constexpr size_t WS_CTL = 0, CTL_ZERO_BYTES = 1 * MiB;
constexpr size_t WS_W1T = 1 * MiB;
constexpr size_t WS_WKVT = 13 * MiB;
constexpr size_t WS_WFOT = 15 * MiB, WS_WNAT = 16 * MiB, WS_WMOT = 17 * MiB;
constexpr size_t WS_WOUTT = 18 * MiB;
constexpr size_t WS_WRT = 20 * MiB;
constexpr size_t WS_F64 = 20 * MiB + 256 * 1024;
constexpr size_t WS_C128 = 20 * MiB + 320 * 1024;
constexpr size_t WS_LIST = 21 * MiB;
constexpr size_t WS_REC = 29 * MiB;
constexpr size_t WS_R1 = 30 * MiB;
constexpr size_t WS_R2 = 94 * MiB;
constexpr size_t WS_R3 = 158 * MiB;
constexpr size_t WS_R4 = 222 * MiB;
constexpr size_t WS_R5 = 286 * MiB;
constexpr size_t WS_R6 = 350 * MiB;
constexpr size_t WS_KVM = 542 * MiB;
constexpr size_t WS_MEMB = 544 * MiB;
constexpr size_t WS_END = 546 * MiB;
constexpr size_t WS_XB = WS_R1, WS_T1 = WS_R1, WS_H = WS_R1;
constexpr size_t WS_ZT = WS_R2, WS_Y = WS_R4 + 32 * MiB;
constexpr size_t WS_Q = WS_R3, WS_K = WS_R3 + 32 * MiB, WS_MERGED = WS_R3;
constexpr size_t WS_VT = WS_R4, WS_QM = WS_R4 + 32 * MiB;
constexpr size_t WS_ONA = WS_R5, WS_OMEM = WS_R5 + 32 * MiB;
constexpr size_t WS_GATES = WS_R6, WS_WGUT = WS_R6, WS_WDT = WS_R6 + 128 * MiB;
constexpr size_t WS_V = WS_R4;
constexpr size_t WS_HMOE = 270 * MiB;
constexpr size_t WS_YB = 94 * MiB;
constexpr int CW_BAR = 4096;
constexpr int CW_GCNT = 8192;

constexpr int RING_BYTES = 131072;
constexpr int MISC_OFF = RING_BYTES;
constexpr int LDS_BYTES = 147456;
constexpr int MS_BAR = 0, MS_TSTART = 64, MS_CNT = 512, MS_TILEE = 1024, MS_HIST = 2048, MS_BASE = 2560;

DI unsigned pk2(float lo, float hi) {
    typedef __bf16 bf2 __attribute__((ext_vector_type(2)));
    f32x2 v = {lo, hi};
    bf2 r = __builtin_convertvector(v, bf2);
    return __builtin_bit_cast(unsigned, r);
}
DI float bf_lo(unsigned w) { return __uint_as_float(w << 16); }
DI float bf_hi(unsigned w) { return __uint_as_float(w & 0xffff0000u); }
DI float wave_sum(float v) {
#pragma unroll
    for (int o = 1; o < 64; o <<= 1) v += __shfl_xor(v, o);
    return v;
}
DI float fast_sigmoid(float z) { return __builtin_amdgcn_rcpf(1.0f + __builtin_amdgcn_exp2f(-1.4426950408889634f * z)); }
#define LDS_WAIT() asm volatile("s_waitcnt lgkmcnt(0)" ::: "memory")
#define VM_WAIT() asm volatile("s_waitcnt vmcnt(0)" ::: "memory")

#define XB_TMO      128
#define XB_XCNT(j)  (256  + 64 * (j))
#define XB_XSUB(j)  (1280 + 64 * (j))
#define XB_XGEN(j)  (2304 + 64 * (j))
#define XB_TOP      3328
#define XB_TOPGEN   3392
#define XCD_BAR_WORDS 3456
#define XB_SPIN_CAP (1u << 18)

__device__ __forceinline__ unsigned xb_ld(unsigned* p)              { return __hip_atomic_load(p, __ATOMIC_RELAXED, __HIP_MEMORY_SCOPE_AGENT); }
__device__ __forceinline__ unsigned xb_add(unsigned* p, unsigned v) { return __hip_atomic_fetch_add(p, v, __ATOMIC_RELAXED, __HIP_MEMORY_SCOPE_AGENT); }
__device__ __forceinline__ unsigned xb_xcc_id() { return (unsigned)__builtin_amdgcn_s_getreg((3 << 11) | 20) & 0xFu; }
#define XB_SPIN(cond, bar) do { unsigned _sp = 0; while (cond) { __builtin_amdgcn_s_sleep(1); \
    if ((++_sp & 255u) == 0u) { if (xb_ld(&(bar)[XB_TMO])) break; if (_sp > XB_SPIN_CAP) { atomicAdd(&(bar)[XB_TMO], 1u); break; } } } } while (0)

struct XcdBarrier {
    unsigned* bar; unsigned x;
    volatile LAS unsigned* st;
};
__device__ __forceinline__ XcdBarrier xcd_barrier_post(unsigned* bar, volatile LAS unsigned* st) {
    XcdBarrier b; b.bar = bar; b.x = xb_xcc_id(); b.st = st;
    if (threadIdx.x == 0) (void)xb_add(&bar[XB_XCNT(b.x)], 1u);
    return b;
}
__device__ __forceinline__ void xcd_barrier_complete(unsigned* bar, unsigned x, unsigned& nloc, unsigned& nx) {
    const unsigned G = gridDim.x * gridDim.y * gridDim.z;
    unsigned sum, cnt, mine, sp = 0u;
    for (;;) {
        sum = 0u; cnt = 0u; mine = 0u;
#pragma unroll
        for (unsigned j = 0; j < 16; ++j) { const unsigned c = xb_ld(&bar[XB_XCNT(j)]); sum += c; cnt += (c > 0u) ? 1u : 0u; mine = (j == x) ? c : mine; }
        if (sum == G) break;
        __builtin_amdgcn_s_sleep(1);
        if ((++sp & 255u) == 0u) { if (xb_ld(&bar[XB_TMO])) break; if (sp > XB_SPIN_CAP) { atomicAdd(&bar[XB_TMO], 1u); break; } }
    }
    nloc = mine > 0u ? mine : 1u; nx = cnt > 0u ? cnt : 1u;
}
__device__ __forceinline__ void xcd_barrier(const XcdBarrier& b) {
    asm volatile("s_waitcnt vmcnt(0)" ::: "memory");
    __syncthreads();
    if (threadIdx.x == 0) {
        unsigned* bar = b.bar;
        __builtin_amdgcn_s_waitcnt(0);
        unsigned nloc = b.st[0], nx = b.st[1];
        if (nloc == 0u) { xcd_barrier_complete(bar, b.x, nloc, nx); b.st[0] = nloc; b.st[1] = nx; }
        const unsigned old = xb_add(&bar[XB_XSUB(b.x)], 1u);
        const unsigned gen = old / nloc;
        if (old + 1u == (gen + 1u) * nloc) {
            __builtin_amdgcn_fence(__ATOMIC_RELEASE, "agent");
            asm volatile("s_waitcnt vmcnt(0)" ::: "memory");
            const unsigned og = xb_add(&bar[XB_TOP], 1u);
            const unsigned tg = og / nx;
            if (og + 1u == (tg + 1u) * nx) xb_add(&bar[XB_TOPGEN], 1u);
            else XB_SPIN(xb_ld(&bar[XB_TOPGEN]) == tg, bar);
            __builtin_amdgcn_fence(__ATOMIC_ACQUIRE, "agent");
            xb_add(&bar[XB_XGEN(b.x)], 1u);
            asm volatile("s_waitcnt vmcnt(0)" ::: "memory");
        } else {
            XB_SPIN(xb_ld(&bar[XB_XGEN(b.x)]) == gen, bar);
            __builtin_amdgcn_fence(__ATOMIC_ACQUIRE, "agent");
            asm volatile("s_waitcnt vmcnt(0)" ::: "memory");
        }
    }
    __syncthreads();
}

namespace pg8 {
constexpr int BM = 256, BK = 64, HALF = 128, HTB = HALF * BK * 2, STAGE_BYTES = 8 * HTB;
DI int lds_byte(int r, int c) { const int st = (r >> 4) * 2 + (c >> 5), rr = r & 15, cc = c & 31, ob = rr * 64 + cc * 2; return st * 1024 + (ob ^ (((ob >> 9) & 1) << 5)); }
DI void stage_rc(int b, int& R, int& C) { const int st = b / 1024, sb = b % 1024, swz = sb ^ (((sb >> 9) & 1) << 5); R = (st >> 1) * 16 + swz / 64; C = (st & 1) * 32 + (swz % 64) / 2; }
DI int perm32(int rho) { const int n = rho >> 4, i = rho & 15; return 8 * (i >> 2) + 4 * n + (i & 3); }

struct GU { const char* A; const char* B; int p0, p1, p2, p3; };
typedef f32x4 Acc[2][2][4][2];

DI void tile_order(int L, int nM, int nN, int& pm, int& pn) {
    const int nwg = nM * nN; int wgid = L;
    { const int q = nwg / 8, r = nwg % 8, xcd = wgid % 8, off = wgid / 8; wgid = (xcd < r ? xcd * (q + 1) : r * (q + 1) + (xcd - r) * q) + off; }
    const int nig = 8 * nN, gid = wgid / nig, fm = gid * 8, gsz = (nM - fm) < 8 ? (nM - fm) : 8;
    pm = fm + ((wgid % nig) % gsz); pn = (wgid % nig) / gsz;
}

template <class Epi, class Sched>
DI void gemm_phase(LAS unsigned char* lds, const Sched& S, const Epi& E) {
    const int tid = threadIdx.x, wid = __builtin_amdgcn_readfirstlane(tid >> 6), lane = tid & 63, wr = wid >> 2, wc = wid & 3, fr = lane & 15, fq = lane >> 4;
    const int K = S.K, nt = K / BK;
    int Rs[2], Cs[2];
    unsigned voffB[2], vA[2][2], nA_[2][2];
#pragma unroll
    for (int i = 0; i < 2; ++i) { stage_rc(tid * 16 + i * 8192, Rs[i], Cs[i]); const int Rb = Epi::PERM ? ((Rs[i] & ~31) + perm32(Rs[i] & 31)) : Rs[i];
        voffB[i] = S.rowoffB(Rb) + (unsigned)Cs[i] * 2u;
        vA[0][i] = S.rowoffA(Rs[i]) + (unsigned)Cs[i] * 2u; vA[1][i] = vA[0][i] + S.hstepA(); nA_[0][i] = vA[0][i]; nA_[1][i] = vA[1][i]; }
    const size_t kstep = (size_t)(BK * 2);
    const size_t hstepB = S.hstepB();
    const unsigned ldsw = (unsigned)wid * 1024u;
    const int aoff = lds_byte(wr * 64 + fr, fq * 8), boff = lds_byte(wc * 32 + fr, fq * 8);
#define PG8_SA(b, h) (((b) * 2 + (h)) * HTB)
#define PG8_SB(b, h) ((4 + (b) * 2 + (h)) * HTB)
#define PG8_STAGE2(bufoff, gbase, v0, v1) do { \
        __builtin_amdgcn_global_load_lds((const unsigned*)((const char*)(gbase) + (v0)), (LAS unsigned*)(lds + (bufoff) + ldsw), 16, 0, 0); \
        __builtin_amdgcn_global_load_lds((const unsigned*)((const char*)(gbase) + (v1)), (LAS unsigned*)(lds + (bufoff) + ldsw + 8192), 16, 0, 0); } while (0)
#define PG8_STAGEB(bufoff, gbase) PG8_STAGE2(bufoff, gbase, voffB[0], voffB[1])
#define PG8_LDA(dst, b, h) do { _Pragma("unroll") for (int m = 0; m < 4; ++m) _Pragma("unroll") for (int k = 0; k < 2; ++k) dst[m][k] = *(const LAS bf16x8*)(lds + PG8_SA(b, h) + aoff + m * 2048 + k * 1024); } while (0)
#define PG8_LDB(dst, b, h) do { _Pragma("unroll") for (int n = 0; n < 2; ++n) _Pragma("unroll") for (int k = 0; k < 2; ++k) dst[n][k] = *(const LAS bf16x8*)(lds + PG8_SB(b, h) + boff + n * 2048 + k * 1024); } while (0)
#define PG8_MMA(ai, bj, At, Bt) do { __builtin_amdgcn_s_setprio(1); _Pragma("unroll") for (int m = 0; m < 4; ++m) _Pragma("unroll") for (int n = 0; n < 2; ++n) _Pragma("unroll") for (int k = 0; k < 2; ++k) \
        acc[ai][bj][m][n] = __builtin_amdgcn_mfma_f32_16x16x32_bf16(Bt[n][k], At[m][k], acc[ai][bj][m][n], 0, 0, 0); __builtin_amdgcn_s_setprio(0); } while (0)
#define PG8_WAIT_V(n) asm volatile("s_waitcnt vmcnt(" #n ")" ::: "memory")
#define PG8_WAIT_L(n) asm volatile("s_waitcnt lgkmcnt(" #n ")" ::: "memory")
#define PG8_BAR __builtin_amdgcn_s_barrier()
#define PG8_SCHED __builtin_amdgcn_sched_barrier(0)
    GU cur, nxt; int ui = 0;
    if (!S.next(0, cur)) return;
    Acc acc;
#pragma unroll
    for (int a = 0; a < 2; ++a)
#pragma unroll
        for (int b = 0; b < 2; ++b)
#pragma unroll
            for (int m = 0; m < 4; ++m)
#pragma unroll
                for (int n = 0; n < 2; ++n) acc[a][b][m][n] = (f32x4){0.f, 0.f, 0.f, 0.f};
    bf16x8 At[4][2], B0[2][2], B1[2][2];
    const char* cA = cur.A; const char* cB = cur.B;
    if constexpr (Sched::GATHER) {
#pragma unroll
        for (int i = 0; i < 2; ++i) { vA[0][i] = S.gatherA(cur, Rs[i]) + (unsigned)Cs[i] * 2u; vA[1][i] = S.gatherA(cur, Rs[i] + 128) + (unsigned)Cs[i] * 2u; }
    }
    PG8_STAGEB(PG8_SB(0, 0), cB); PG8_STAGEB(PG8_SB(0, 1), cB + hstepB); PG8_STAGE2(PG8_SA(0, 0), cA, vA[0][0], vA[0][1]); PG8_STAGE2(PG8_SA(0, 1), cA, vA[1][0], vA[1][1]);
    if (wr == 1) PG8_BAR;
    PG8_WAIT_V(2); PG8_BAR;
    PG8_STAGEB(PG8_SB(1, 0), cB + kstep); PG8_STAGE2(PG8_SA(1, 0), cA + kstep, vA[0][0], vA[0][1]); PG8_STAGEB(PG8_SB(1, 1), cB + hstepB + kstep);
    PG8_WAIT_V(6); PG8_BAR;
    for (;;) {
        const bool has_next = S.next(ui + 1, nxt);
        const char* nA = has_next ? nxt.A : cA; const char* nB = has_next ? nxt.B : cB;
        if constexpr (Sched::GATHER) {
            if (has_next) {
#pragma unroll
                for (int i = 0; i < 2; ++i) { nA_[0][i] = S.gatherA(nxt, Rs[i]) + (unsigned)Cs[i] * 2u; nA_[1][i] = S.gatherA(nxt, Rs[i] + 128) + (unsigned)Cs[i] * 2u; }
            } else {
#pragma unroll
                for (int i = 0; i < 2; ++i) { nA_[0][i] = vA[0][i]; nA_[1][i] = vA[1][i]; }
            }
        }
        for (int t = 0; t < nt; t += 2) {
            const bool last = (t == nt - 2);
            const char* a1 = cA + (size_t)(t + 1) * kstep;
            const char* a2 = last ? nA : cA + (size_t)(t + 2) * kstep; const char* b2 = last ? nB : cB + (size_t)(t + 2) * kstep;
            const char* a3 = a2 + kstep; const char* b3 = b2 + kstep;
            unsigned x00 = vA[0][0], x01 = vA[0][1], x10 = vA[1][0], x11 = vA[1][1];
            if constexpr (Sched::GATHER) { if (last) { x00 = nA_[0][0]; x01 = nA_[0][1]; x10 = nA_[1][0]; x11 = nA_[1][1]; } }
            PG8_LDB(B0, 0, 0); PG8_LDB(B1, 0, 1); PG8_SCHED; PG8_LDA(At, 0, 0); PG8_STAGE2(PG8_SA(1, 1), a1, vA[1][0], vA[1][1]);
            PG8_WAIT_V(8); PG8_WAIT_L(0); PG8_BAR; PG8_MMA(0, 0, At, B0); PG8_MMA(0, 1, At, B1); PG8_BAR; PG8_SCHED;
            PG8_LDA(At, 0, 1); PG8_STAGEB(PG8_SB(0, 0), b2); PG8_STAGEB(PG8_SB(0, 1), b2 + hstepB); PG8_STAGE2(PG8_SA(0, 0), a2, x00, x01);
            PG8_WAIT_V(8); PG8_WAIT_L(0); PG8_BAR; PG8_MMA(1, 0, At, B0); PG8_MMA(1, 1, At, B1); PG8_BAR; PG8_SCHED;
            PG8_LDB(B0, 1, 0); PG8_LDB(B1, 1, 1); PG8_SCHED; PG8_LDA(At, 1, 0); PG8_STAGE2(PG8_SA(0, 1), a2, x10, x11);
            PG8_WAIT_V(8); PG8_WAIT_L(0); PG8_BAR; PG8_MMA(0, 0, At, B0); PG8_MMA(0, 1, At, B1); PG8_BAR; PG8_SCHED;
            PG8_LDA(At, 1, 1); PG8_STAGEB(PG8_SB(1, 0), b3); PG8_STAGEB(PG8_SB(1, 1), b3 + hstepB); PG8_STAGE2(PG8_SA(1, 0), a3, x00, x01);
            PG8_WAIT_V(8); PG8_WAIT_L(0); PG8_BAR; PG8_MMA(1, 0, At, B0); PG8_MMA(1, 1, At, B1); PG8_BAR; PG8_SCHED;
        }
        if (wr == 0) PG8_BAR;
        E(acc, cur, wr, wc, fr, fq);
        if (!has_next) break;
        cur = nxt; cA = nA; cB = nB; ++ui;
        if constexpr (Sched::GATHER) {
#pragma unroll
            for (int i = 0; i < 2; ++i) { vA[0][i] = nA_[0][i]; vA[1][i] = nA_[1][i]; }
        }
        if (wr == 1) PG8_BAR;
    }
    PG8_WAIT_V(0);
    PG8_BAR;
#undef PG8_SA
#undef PG8_SB
#undef PG8_STAGE2
#undef PG8_STAGEB
#undef PG8_LDA
#undef PG8_LDB
#undef PG8_MMA
#undef PG8_WAIT_V
#undef PG8_WAIT_L
#undef PG8_BAR
#undef PG8_SCHED
}
}
using pg8::GU; using pg8::Acc;

struct Args { const float* in[22]; float* out; unsigned char* ws; int ph_lo, ph_hi; };
struct Frame {
    LAS unsigned char* lds;
    int tid, lane, wave, G, vcu;
    unsigned char* ws;
};
enum { IN_X = 0, IN_MEM, IN_WIN, IN_WGATE, IN_BGATE, IN_WMEMKV, IN_RPB, IN_WFO, IN_WNAO, IN_WMEMO, IN_WOUT, IN_LN1G, IN_LN1B,
       IN_WRG, IN_BRG, IN_WRE, IN_BRE, IN_WEG, IN_WEU, IN_WED, IN_LN2G, IN_LN2B };

DI void cvt_row_1024(const float* src, bf16_t* dst, int lane) {
#pragma unroll
    for (int j = 0; j < 2; ++j) {
        const f32x4 a = *(const f32x4*)(src + j * 512 + lane * 8), b = *(const f32x4*)(src + j * 512 + lane * 8 + 4);
        u32x4 o; o.x = pk2(a.x, a.y); o.y = pk2(a.z, a.w); o.z = pk2(b.x, b.y); o.w = pk2(b.z, b.w);
        *(u32x4*)(dst + j * 512 + lane * 8) = o;
    }
}
DI void tr_tile(const float* W, int ldw, int colbase, int k0, bf16_t* WT, int ldt, int drow0, LAS float* scr, int lane) {
#pragma unroll 8
    for (int i = 0; i < 32; ++i) { const int kk = 2 * i + (lane >> 5); scr[kk * 33 + (lane & 31)] = W[(size_t)(k0 + kk) * ldw + colbase + (lane & 31)]; }
    LDS_WAIT(); asm volatile("" ::: "memory");
    const int c = lane & 7;
#pragma unroll
    for (int j = 0; j < 4; ++j) { const int n = (lane >> 3) + 8 * j; const LAS float* s = scr + (8 * c) * 33 + n;
        u32x4 o; o.x = pk2(s[0 * 33], s[1 * 33]); o.y = pk2(s[2 * 33], s[3 * 33]); o.z = pk2(s[4 * 33], s[5 * 33]); o.w = pk2(s[6 * 33], s[7 * 33]);
        *(u32x4*)(WT + (size_t)(drow0 + n) * ldt + k0 + 8 * c) = o; }
    LDS_WAIT(); asm volatile("" ::: "memory");
}
DI void tr_item(const float* W, int ldw, int col0, int ncols, bf16_t* WT, int K, int row_off, LAS float* scr, int item, int lane) {
    const int nblk = ncols / 32, kb = item / nblk, nb = item % nblk;
    tr_tile(W, ldw, col0 + 32 * nb, 64 * kb, WT, K, row_off + 32 * nb, scr, lane);
}
DI void fold_item(const float* w_in, bf16_t* W1t, LAS float* scr, int item, int lane) {
    const int g = item >> 7, k0 = (item & 127) * 8;
    LAS float* wt = scr;
    LAS float* tc = scr + 1024;
    LAS float* ts = scr + 1152;
#pragma unroll
    for (int j = 0; j < 4; ++j) { const int idx = lane + 64 * j, kk = idx >> 5, c4 = idx & 31;
        const f32x4 v = *(const f32x4*)(w_in + (size_t)(k0 + kk) * 2560 + g * 128 + 4 * c4);
        *(LAS f32x4*)(wt + kk * 128 + 4 * c4) = v; }
#pragma unroll
    for (int j = 0; j < 2; ++j) { const int i = lane + 64 * j; float sv, cv; sincospif((float)i * (1.0f / 64.0f), &sv, &cv); tc[i] = cv; ts[i] = sv; }
    LDS_WAIT(); asm volatile("" ::: "memory");
#pragma unroll 1
    for (int j = 0; j < 2; ++j) {
        const int cp = lane + 64 * j;
        float re[8], im[8];
#pragma unroll
        for (int kk = 0; kk < 8; ++kk) { re[kk] = 0.f; im[kk] = 0.f; }
        for (int c = 0; c < 128; ++c) {
            const int idx = (c * cp) & 127; const float cs = tc[idx], sn = ts[idx];
#pragma unroll
            for (int kk = 0; kk < 8; ++kk) { const float w = wt[kk * 128 + c]; re[kk] += w * cs; im[kk] -= w * sn; }
        }
        const float sc = 0.08838834764831845f;
        u32x4 o;
        o.x = pk2(re[0] * sc, re[1] * sc); o.y = pk2(re[2] * sc, re[3] * sc); o.z = pk2(re[4] * sc, re[5] * sc); o.w = pk2(re[6] * sc, re[7] * sc);
        *(u32x4*)(W1t + (size_t)(g * 256 + cp) * 1024 + k0) = o;
        o.x = pk2(im[0] * sc, im[1] * sc); o.y = pk2(im[2] * sc, im[3] * sc); o.z = pk2(im[4] * sc, im[5] * sc); o.w = pk2(im[6] * sc, im[7] * sc);
        *(u32x4*)(W1t + (size_t)(g * 256 + 128 + cp) * 1024 + k0) = o;
    }
    LDS_WAIT(); asm volatile("" ::: "memory");
}
DI void p0_prologue(const Frame& F, const Args& a) {
    LAS float* scr = (LAS float*)(F.lds + F.wave * 16384);
    const int gw = F.vcu * 8 + F.wave, NGW = F.G * 8, lane = F.lane;
    unsigned char* ws = F.ws;
    bf16_t* W1t = (bf16_t*)(ws + WS_W1T);
    constexpr int I_IN = 16 * 64, I_GATE = 16 * 96, I_KV = 16 * 32, I_BR = 8 * 32, I_OUT = 16 * 32, I_FOLD = 512;
    constexpr int NITEMS = I_FOLD + I_IN + I_GATE + I_KV + 3 * I_BR + I_OUT;
    for (int it = gw; it < NITEMS; it += NGW) {
        int r = it;
        if (r < I_FOLD) { fold_item(a.in[IN_WIN], W1t, scr, r, lane); continue; } r -= I_FOLD;
        if (r < I_IN) { tr_item(a.in[IN_WIN], 2560, 512, 2048, W1t, 1024, 1024, scr, r, lane); continue; } r -= I_IN;
        if (r < I_GATE) { tr_item(a.in[IN_WGATE], 3072, 0, 3072, W1t, 1024, 3072, scr, r, lane); continue; } r -= I_GATE;
        if (r < I_KV) { tr_item(a.in[IN_WMEMKV], 1024, 0, 1024, (bf16_t*)(ws + WS_WKVT), 1024, 0, scr, r, lane); continue; } r -= I_KV;
        if (r < I_BR) { tr_item(a.in[IN_WFO], 1024, 0, 1024, (bf16_t*)(ws + WS_WFOT), 512, 0, scr, r, lane); continue; } r -= I_BR;
        if (r < I_BR) { tr_item(a.in[IN_WNAO], 1024, 0, 1024, (bf16_t*)(ws + WS_WNAT), 512, 0, scr, r, lane); continue; } r -= I_BR;
        if (r < I_BR) { tr_item(a.in[IN_WMEMO], 1024, 0, 1024, (bf16_t*)(ws + WS_WMOT), 512, 0, scr, r, lane); continue; } r -= I_BR;
        tr_item(a.in[IN_WOUT], 1024, 0, 1024, (bf16_t*)(ws + WS_WOUTT), 1024, 0, scr, r, lane);
    }
    for (int m = gw; m < T; m += NGW) cvt_row_1024(a.in[IN_X] + (size_t)m * DM, (bf16_t*)(ws + WS_XB) + (size_t)m * DM, lane);
    for (int m = gw; m < NBATCH * MEML; m += NGW) cvt_row_1024(a.in[IN_MEM] + (size_t)m * DM, (bf16_t*)(ws + WS_MEMB) + (size_t)m * DM, lane);
    const int gt = F.vcu * 512 + F.tid, NGT = F.G * 512;
    { bf16_t* wr = (bf16_t*)(ws + WS_WRT);
      for (int i = gt; i < 80 * 1024; i += NGT) { const int r = i >> 10, k = i & 1023;
          const float v = r < 64 ? a.in[IN_WRE][k * 64 + r] : (r < 72 ? a.in[IN_WRG][k * 8 + (r - 64)] : 0.f);
          wr[i] = (bf16_t)(pk2(v, 0.f) & 0xffffu); } }
    { bf16_t* f = (bf16_t*)(ws + WS_F64);
      for (int i = gt; i < 128 * 128; i += NGT) { const int j = i & 7, ln = (i >> 3) & 63, nt = (i >> 9) & 7, ks = i >> 12;
          const int k = 32 * ks + 8 * (ln >> 4) + j, m = 16 * nt + (ln & 15), ri = k >> 6, n1 = k & 63, rip = m >> 6, k1 = m & 63;
          float sv, cv; sincospif((float)((n1 * k1) & 63) * (1.0f / 32.0f), &sv, &cv);
          const float v = (ri == rip) ? cv : (ri == 1 ? sv : -sv);
          f[i] = (bf16_t)(pk2(v * 0.125f, 0.f) & 0xffffu); } }
    { bf16_t* f = (bf16_t*)(ws + WS_C128);
      for (int i = gt; i < 256 * 128; i += NGT) { const int j = i & 7, ln = (i >> 3) & 63, nt = (i >> 9) & 7, ks = i >> 12;
          const int k = 32 * ks + 8 * (ln >> 4) + j, k2 = 16 * nt + (ln & 15), rip = k >> 7, n2 = k & 127;
          float sv, cv; sincospif((float)((n2 * k2) & 127) * (1.0f / 64.0f), &sv, &cv);
          f[i] = (bf16_t)(pk2((rip == 0 ? cv : sv) * 0.08838834764831845f, 0.f) & 0xffffu); } }
}
DI void p_expert_cvt(const Frame& F, const Args& a) {
    LAS float* scr = (LAS float*)(F.lds + F.wave * 16384);
    const int gw = F.vcu * 8 + F.wave, NGW = F.G * 8, lane = F.lane;
    bf16_t* wgu = (bf16_t*)(F.ws + WS_WGUT); bf16_t* wd = (bf16_t*)(F.ws + WS_WDT);
    for (int it = gw; it < NEXP * 768; it += NGW) {
        const int e = it / 768; int r = it % 768;
        if (r < 512) { const int up = r >> 8; r &= 255; const int kb = r >> 4, nb = r & 15, n0 = 32 * nb;
            const float* W = (up ? a.in[IN_WEU] : a.in[IN_WEG]) + (size_t)e * 1024 * 512;
            tr_tile(W, 512, n0, 64 * kb, wgu + (size_t)e * 1024 * 1024, 1024, (n0 >> 7) * 256 + up * 128 + (n0 & 127), scr, lane);
        } else { r -= 512; const int kb = r >> 5, nb = r & 31;
            tr_tile(a.in[IN_WED] + (size_t)e * 512 * 1024, 1024, 32 * nb, 64 * kb, wd + (size_t)e * 1024 * 512, 512, 32 * nb, scr, lane);
        }
    }
}

template <bool BIAS> struct EpiP1 {
    static constexpr bool PERM = true;
    unsigned char* ws; const float* bgate;
    DI void operator()(Acc& acc, const GU& u, int wr, int wc, int fr, int fq) const {
        bf16_t* base; int ld; float sc = 1.f;
        if constexpr (BIAS) { base = (bf16_t*)(ws + WS_GATES) + (size_t)u.p1 * 256 * 3072 + u.p2 * 256; ld = 3072; }
        else switch (u.p0) {
            case 0: base = (bf16_t*)(ws + WS_ZT) + (size_t)u.p1 * 256 * 8192 + (size_t)u.p2 * 256; ld = 8192; break;
            case 1: base = (bf16_t*)(ws + WS_Q) + (size_t)u.p1 * 256 * 512 + u.p2 * 256; ld = 512; sc = 0.125f; break;
            case 2: base = (bf16_t*)(ws + WS_K) + (size_t)u.p1 * 256 * 512 + u.p2 * 256; ld = 512; break;
            case 3: base = (bf16_t*)(ws + WS_VT) + (size_t)u.p1 * 256 * 8192 + (size_t)u.p2 * 256; ld = 8192; break;
            case 4: base = (bf16_t*)(ws + WS_QM) + (size_t)u.p1 * 256 * 512 + u.p2 * 256; ld = 512; sc = 0.08838834764831845f; break;
            case 6: base = (bf16_t*)(ws + WS_KVM) + (size_t)u.p1 * 256 * 512 + u.p2 * 256; ld = 512; break;
            default: base = (bf16_t*)(ws + WS_KVM + MiB) + (size_t)u.p1 * 256 * 256; ld = 256; break;
        }
        const int row0 = wr * 64 + fr, col0 = wc * 32 + 8 * fq;
        f32x4 bv[2][2];
        if constexpr (BIAS) {
            const float* bias = bgate + u.p2 * 256 + col0;
#pragma unroll
            for (int bj = 0; bj < 2; ++bj)
#pragma unroll
                for (int n = 0; n < 2; ++n) bv[bj][n] = *(const f32x4*)(bias + bj * 128 + 4 * n);
        }
#pragma unroll
        for (int ai = 0; ai < 2; ++ai)
#pragma unroll
            for (int m = 0; m < 4; ++m) { bf16_t* rowp = base + (size_t)(row0 + ai * 128 + m * 16) * ld + col0;
#pragma unroll
                for (int bj = 0; bj < 2; ++bj) { f32x4 v0 = acc[ai][bj][m][0], v1 = acc[ai][bj][m][1];
                    if constexpr (BIAS) {
                        v0 = v0 + bv[bj][0]; v1 = v1 + bv[bj][1];
#pragma unroll
                        for (int j = 0; j < 4; ++j) { v0[j] = fmaxf(fast_sigmoid(v0[j]), 9.5367431640625e-07f); v1[j] = fmaxf(fast_sigmoid(v1[j]), 9.5367431640625e-07f); }
                    } else { v0 = v0 * sc; v1 = v1 * sc; }
                    u32x4 w; w.x = pk2(v0[0], v0[1]); w.y = pk2(v0[2], v0[3]); w.z = pk2(v1[0], v1[1]); w.w = pk2(v1[2], v1[3]);
                    *(u32x4*)(rowp + bj * 128) = w;
                    acc[ai][bj][m][0] = (f32x4){0.f, 0.f, 0.f, 0.f}; acc[ai][bj][m][1] = (f32x4){0.f, 0.f, 0.f, 0.f}; } }
    }
};
struct SchedP1F {
    static constexpr bool GATHER = false;
    int K, G, c; const char* xb; const char* w1t;
    DI unsigned rowoffA(int r) const { return (unsigned)r * 2048u; }
    DI unsigned hstepA() const { return 128u * 2048u; }
    DI unsigned rowoffB(int r) const { return (unsigned)((r & 63) * 128 + (r >> 6)) * 2048u; }
    DI unsigned hstepB() const { return 2u * 2048u; }
    DI unsigned gatherA(const GU&, int) const { return 0u; }
    DI bool next(int i, GU& u) const {
        const int L = i * G + c; if (L >= 512) return false;
        int pm, pn; pg8::tile_order(L, 128, 4, pm, pn);
        const int b = pm >> 5, pp = pm & 31;
        u.A = w1t + (size_t)pn * 256 * 2048; u.B = xb + ((size_t)b * 8192 + 4 * pp) * 2048;
        u.p0 = 0; u.p1 = b * 4 + pn; u.p2 = pp; u.p3 = 0; return true;
    }
};
struct SchedP1a {
    static constexpr bool GATHER = false;
    int K, G, c; const char* xb; const char* w1t; const char* memb; const char* wkvt;
    DI unsigned rowoffA(int r) const { return (unsigned)r * 2048u; }
    DI unsigned hstepA() const { return 128u * 2048u; }
    DI unsigned rowoffB(int r) const { return (unsigned)r * 2048u; }
    DI unsigned hstepB() const { return 128u * 2048u; }
    DI unsigned gatherA(const GU&, int) const { return 0u; }
    DI bool next(int i, GU& u) const {
        const int L = i * G + c; u.p3 = 0;
        if (L < 1024) {
            int pm, pn; pg8::tile_order(L, 128, 8, pm, pn);
            const char* xt = xb + (size_t)pm * 256 * 2048;
            if (pn < 2)       { u.A = xt; u.B = w1t + (size_t)(1024 + 256 * pn) * 2048; u.p0 = 1; u.p1 = pm; u.p2 = pn; }
            else if (pn < 4)  { u.A = xt; u.B = w1t + (size_t)(1536 + 256 * (pn - 2)) * 2048; u.p0 = 2; u.p1 = pm; u.p2 = pn - 2; }
            else if (pn < 6)  { u.A = w1t + (size_t)(2048 + 256 * (pn - 4)) * 2048; u.B = xt; u.p0 = 3; u.p1 = (pm >> 5) * 2 + (pn - 4); u.p2 = pm & 31; }
            else              { u.A = xt; u.B = w1t + (size_t)(2560 + 256 * (pn - 6)) * 2048; u.p0 = 4; u.p1 = pm; u.p2 = pn - 6; }
            return true;
        }
        const int j = L - 1024; if (j >= 16) return false;
        if (j < 8) { const int pm = j >> 1, pn = j & 1; u.A = memb + (size_t)pm * 256 * 2048; u.B = wkvt + (size_t)pn * 256 * 2048; u.p0 = 6; u.p1 = pm; u.p2 = pn; }
        else { const int f = (j - 8) >> 2, b = (j - 8) & 3; u.A = wkvt + (size_t)(512 + 256 * f) * 2048; u.B = memb + (size_t)b * 256 * 2048; u.p0 = 7; u.p1 = b * 2 + f; u.p2 = 0; }
        return true;
    }
};
struct SchedP1g {
    static constexpr bool GATHER = false;
    int K, G, c; const char* xb; const char* w1t;
    DI unsigned rowoffA(int r) const { return (unsigned)r * 2048u; }
    DI unsigned hstepA() const { return 128u * 2048u; }
    DI unsigned rowoffB(int r) const { return (unsigned)r * 2048u; }
    DI unsigned hstepB() const { return 128u * 2048u; }
    DI unsigned gatherA(const GU&, int) const { return 0u; }
    DI bool next(int i, GU& u) const {
        const int L = i * G + c; if (L >= 1536) return false;
        int pm, pn; pg8::tile_order(L, 128, 12, pm, pn);
        u.A = xb + (size_t)pm * 256 * 2048; u.B = w1t + (size_t)(3072 + 256 * pn) * 2048; u.p0 = 5; u.p1 = pm; u.p2 = pn; u.p3 = 0; return true;
    }
};

struct EpiMerge {
    static constexpr bool PERM = true;
    const bf16_t* gates; bf16_t* merged;
    DI void operator()(Acc& acc, const GU& u, int wr, int wc, int fr, int fq) const {
        const int seg = u.p0, pm = u.p1, pn = u.p2;
        const int row0 = pm * 256 + wr * 64 + fr, col0 = pn * 256 + wc * 32 + 8 * fq;
#pragma unroll
        for (int ai = 0; ai < 2; ++ai)
#pragma unroll
            for (int m = 0; m < 4; ++m) { const size_t r = (size_t)(row0 + ai * 128 + m * 16);
#pragma unroll
                for (int bj = 0; bj < 2; ++bj) {
                    const bf16_t* gp = gates + r * 3072 + seg * 1024 + col0 + bj * 128;
                    const u32x4 ga = *(const u32x4*)gp;
                    float g[8] = {bf_lo(ga.x), bf_hi(ga.x), bf_lo(ga.y), bf_hi(ga.y), bf_lo(ga.z), bf_hi(ga.z), bf_lo(ga.w), bf_hi(ga.w)};
                    if (seg < 2) {
                        const u32x4 gb = *(const u32x4*)(gp + 1024);
                        const float h[8] = {bf_lo(gb.x), bf_hi(gb.x), bf_lo(gb.y), bf_hi(gb.y), bf_lo(gb.z), bf_hi(gb.z), bf_lo(gb.w), bf_hi(gb.w)};
#pragma unroll
                        for (int j = 0; j < 8; ++j) g[j] = g[j] * __builtin_amdgcn_rcpf(h[j]);
                    }
                    f32x4 v0 = acc[ai][bj][m][0], v1 = acc[ai][bj][m][1];
#pragma unroll
                    for (int j = 0; j < 4; ++j) { v0[j] *= g[j]; v1[j] *= g[4 + j]; }
                    if (seg == 2) {
                        u32x4 w; w.x = pk2(v0[0], v0[1]); w.y = pk2(v0[2], v0[3]); w.z = pk2(v1[0], v1[1]); w.w = pk2(v1[2], v1[3]);
                        *(u32x4*)(merged + r * 1024 + col0 + bj * 128) = w;
                        v0 = (f32x4){0.f, 0.f, 0.f, 0.f}; v1 = v0;
                    }
                    acc[ai][bj][m][0] = v0; acc[ai][bj][m][1] = v1; } }
    }
};
struct SchedMerge {
    static constexpr bool GATHER = false;
    int K, G, c; const char* a0; const char* b0;
    DI unsigned rowoffA(int r) const { return (unsigned)r * 1024u; }
    DI unsigned hstepA() const { return 128u * 1024u; }
    DI unsigned rowoffB(int r) const { return (unsigned)r * 1024u; }
    DI unsigned hstepB() const { return 128u * 1024u; }
    DI unsigned gatherA(const GU&, int) const { return 0u; }
    DI bool next(int i, GU& u) const {
        const int tile = i / 3, seg = i - 3 * tile, L = tile * G + c; if (L >= 512) return false;
        int pm, pn; pg8::tile_order(L, 128, 4, pm, pn);
        u.A = a0 + (size_t)seg * (32 * MiB) + (size_t)pm * 256 * 1024; u.B = b0 + (size_t)seg * MiB + (size_t)pn * 256 * 1024; u.p0 = seg; u.p1 = pm; u.p2 = pn; u.p3 = 0; return true;
    }
};
static_assert(WS_ONA == WS_Y + 32 * MiB && WS_OMEM == WS_Y + 64 * MiB && WS_WNAT == WS_WFOT + MiB && WS_WMOT == WS_WFOT + 2 * MiB, "P4 segment strides");

struct EpiOut {
    static constexpr bool PERM = false;
    const float* x; float* v;
    DI void operator()(Acc& acc, const GU& u, int wr, int wc, int fr, int fq) const {
        const int row0 = u.p1 * 256 + wr * 64 + fr, col0 = u.p2 * 256 + wc * 32 + 4 * fq;
#pragma unroll
        for (int ai = 0; ai < 2; ++ai)
#pragma unroll
            for (int m = 0; m < 4; ++m) { const size_t off = (size_t)(row0 + ai * 128 + m * 16) * 1024 + col0;
#pragma unroll
                for (int bj = 0; bj < 2; ++bj)
#pragma unroll
                    for (int n = 0; n < 2; ++n) { const f32x4 xv = *(const f32x4*)(x + off + bj * 128 + n * 16);
                        *(f32x4*)(v + off + bj * 128 + n * 16) = xv * ALPHA + acc[ai][bj][m][n]; acc[ai][bj][m][n] = (f32x4){0.f, 0.f, 0.f, 0.f}; } }
    }
};
struct SchedOut {
    static constexpr bool GATHER = false;
    int K, G, c; const char* a; const char* b;
    DI unsigned rowoffA(int r) const { return (unsigned)r * 2048u; }
    DI unsigned hstepA() const { return 128u * 2048u; }
    DI unsigned rowoffB(int r) const { return (unsigned)r * 2048u; }
    DI unsigned hstepB() const { return 128u * 2048u; }
    DI unsigned gatherA(const GU&, int) const { return 0u; }
    DI bool next(int i, GU& u) const {
        const int L = i * G + c; if (L >= 512) return false;
        int pm, pn; pg8::tile_order(L, 128, 4, pm, pn);
        u.A = a + (size_t)pm * 256 * 2048; u.B = b + (size_t)pn * 256 * 2048; u.p0 = 0; u.p1 = pm; u.p2 = pn; u.p3 = 0; return true;
    }
};

DI void moe_tables(const Frame& F) {
    LAS int* tstart = (LAS int*)(F.lds + MISC_OFF + MS_TSTART); LAS int* cnt = (LAS int*)(F.lds + MISC_OFF + MS_CNT);
    LAS unsigned short* tile_e = (LAS unsigned short*)(F.lds + MISC_OFF + MS_TILEE);
    const unsigned* gcnt = (const unsigned*)(F.ws + WS_CTL) + CW_GCNT;
    __syncthreads();
    if (F.tid < 64) { int c = (int)__hip_atomic_load(gcnt + F.tid, __ATOMIC_RELAXED, __HIP_MEMORY_SCOPE_AGENT); c = c > LIST_CAP ? LIST_CAP : c; cnt[F.tid] = c; }
    __syncthreads();
    if (F.tid == 0) { int s = 0; for (int e = 0; e < 64; ++e) { tstart[e] = s; s += (cnt[e] + 255) >> 8; } tstart[64] = s; }
    __syncthreads();
    if (F.tid < 64) { const int e = F.tid; for (int t = tstart[e]; t < tstart[e + 1]; ++t) tile_e[t] = (unsigned short)e; }
    __syncthreads();
}
struct SchedMoeGU {
    static constexpr bool GATHER = true;
    int K, G, c; const char* h; const char* wgu; const int* list; LAS unsigned char* misc;
    DI unsigned rowoffA(int) const { return 0u; }
    DI unsigned hstepA() const { return 0u; }
    DI unsigned rowoffB(int r) const { return (unsigned)r * 2048u; }
    DI unsigned hstepB() const { return 128u * 2048u; }
    DI unsigned gatherA(const GU& u, int r) const {
        const LAS int* cnt = (const LAS int*)(misc + MS_CNT);
        const int slot = u.p1 * 256 + r; const int tok = slot < cnt[u.p0] ? list[(size_t)u.p0 * LIST_CAP + slot] : 0;
        return (unsigned)tok * 2048u;
    }
    DI bool next(int i, GU& u) const {
        const LAS int* tstart = (const LAS int*)(misc + MS_TSTART); const LAS unsigned short* tile_e = (const LAS unsigned short*)(misc + MS_TILEE);
        const int L = i * G + c, tau = L >> 2, pn = L & 3; if (tau >= tstart[64]) return false;
        const int e = tile_e[tau];
        u.A = h; u.B = wgu + ((size_t)e * 1024 + 256 * pn) * 2048; u.p0 = e; u.p1 = tau - tstart[e]; u.p2 = pn; u.p3 = tau; return true;
    }
};
struct EpiSwiGLU {
    static constexpr bool PERM = true;
    bf16_t* H;
    DI void operator()(Acc& acc, const GU& u, int wr, int wc, int fr, int fq) const {
        const int row0 = u.p3 * 256 + wr * 64 + fr, col0 = u.p2 * 128 + wc * 32 + 8 * fq;
#pragma unroll
        for (int ai = 0; ai < 2; ++ai)
#pragma unroll
            for (int m = 0; m < 4; ++m) {
                float o[8];
#pragma unroll
                for (int n = 0; n < 2; ++n)
#pragma unroll
                    for (int j = 0; j < 4; ++j) { const float g = acc[ai][0][m][n][j], up = acc[ai][1][m][n][j]; o[4 * n + j] = g * fast_sigmoid(g) * up; }
                u32x4 w; w.x = pk2(o[0], o[1]); w.y = pk2(o[2], o[3]); w.z = pk2(o[4], o[5]); w.w = pk2(o[6], o[7]);
                *(u32x4*)(H + (size_t)(row0 + ai * 128 + m * 16) * 512 + col0) = w;
#pragma unroll
                for (int bj = 0; bj < 2; ++bj)
#pragma unroll
                    for (int n = 0; n < 2; ++n) acc[ai][bj][m][n] = (f32x4){0.f, 0.f, 0.f, 0.f}; }
    }
};
struct SchedMoeD {
    static constexpr bool GATHER = false;
    int K, G, c; const char* H; const char* wd; LAS unsigned char* misc;
    DI unsigned rowoffA(int r) const { return (unsigned)r * 1024u; }
    DI unsigned hstepA() const { return 128u * 1024u; }
    DI unsigned rowoffB(int r) const { return (unsigned)r * 1024u; }
    DI unsigned hstepB() const { return 128u * 1024u; }
    DI unsigned gatherA(const GU&, int) const { return 0u; }
    DI bool next(int i, GU& u) const {
        const LAS int* tstart = (const LAS int*)(misc + MS_TSTART); const LAS unsigned short* tile_e = (const LAS unsigned short*)(misc + MS_TILEE);
        const int L = i * G + c, tau = L >> 2, pn = L & 3; if (tau >= tstart[64]) return false;
        const int e = tile_e[tau];
        u.A = H + (size_t)tau * 256 * 1024; u.B = wd + ((size_t)e * 1024 + 256 * pn) * 1024; u.p0 = e; u.p1 = 0; u.p2 = pn; u.p3 = tau; return true;
    }
};
struct EpiDown {
    static constexpr bool PERM = true;
    bf16_t* Y;
    DI void operator()(Acc& acc, const GU& u, int wr, int wc, int fr, int fq) const {
        const int row0 = u.p3 * 256 + wr * 64 + fr, col0 = u.p2 * 256 + wc * 32 + 8 * fq;
#pragma unroll
        for (int ai = 0; ai < 2; ++ai)
#pragma unroll
            for (int m = 0; m < 4; ++m) { bf16_t* rowp = Y + (size_t)(row0 + ai * 128 + m * 16) * 1024 + col0;
#pragma unroll
                for (int bj = 0; bj < 2; ++bj) { const f32x4 v0 = acc[ai][bj][m][0], v1 = acc[ai][bj][m][1];
                    u32x4 w; w.x = pk2(v0[0], v0[1]); w.y = pk2(v0[2], v0[3]); w.z = pk2(v1[0], v1[1]); w.w = pk2(v1[2], v1[3]);
                    *(u32x4*)(rowp + bj * 128) = w;
                    acc[ai][bj][m][0] = (f32x4){0.f, 0.f, 0.f, 0.f}; acc[ai][bj][m][1] = (f32x4){0.f, 0.f, 0.f, 0.f}; } }
    }
};

#define MFMA16(a, b, c) __builtin_amdgcn_mfma_f32_16x16x32_bf16((a), (b), (c), 0, 0, 0)
DI void fft1_item(const bf16_t* zt, bf16_t* t1, const LAS unsigned char* fb, int item, int lane) {
    const int n2h = item & 1, c = (item >> 1) & 127, g = (item >> 8) & 3, b = item >> 10;
    const int fr = lane & 15, fq = lane >> 4, n2_0 = 64 * n2h;
#pragma unroll 1
    for (int a2 = 0; a2 < 2; ++a2) {
        f32x4 acc[2][8];
#pragma unroll
        for (int mt = 0; mt < 2; ++mt)
#pragma unroll
            for (int nt = 0; nt < 8; ++nt) acc[mt][nt] = (f32x4){0.f, 0.f, 0.f, 0.f};
        bf16x8 a[4][2];
#pragma unroll
        for (int ks = 0; ks < 4; ++ks) { const int ri = ks >> 1, n1_0 = 32 * (ks & 1) + 8 * fq;
            const bf16_t* rowb = zt + (size_t)(b * 1024 + g * 256 + ri * 128 + c) * 8192 + n1_0;
#pragma unroll
            for (int mt = 0; mt < 2; ++mt) { const int n2 = n2_0 + 32 * a2 + 8 * (fr >> 2) + 4 * mt + (fr & 3);
                a[ks][mt] = *(const bf16x8*)(rowb + n2 * 64); } }
#pragma unroll
        for (int ks = 0; ks < 4; ++ks)
#pragma unroll
            for (int nt = 0; nt < 8; ++nt) { const bf16x8 bf = *(const LAS bf16x8*)(fb + ((ks * 8 + nt) * 64 + lane) * 16);
#pragma unroll
                for (int mt = 0; mt < 2; ++mt) acc[mt][nt] = MFMA16(a[ks][mt], bf, acc[mt][nt]);
                if (nt == 7) asm volatile("" ::: "memory"); }
#pragma unroll
        for (int ntl = 0; ntl < 4; ++ntl) { const int k1 = 16 * ntl + fr; float ore[8], oim[8];
#pragma unroll
            for (int e = 0; e < 8; ++e) { const int n2 = n2_0 + 32 * a2 + 8 * fq + e;
                const float re = acc[e >> 2][ntl][e & 3], im = acc[e >> 2][ntl + 4][e & 3];
                const float ang = (float)((n2 * k1) & 8191) * (1.0f / 8192.0f);
                const float cs = __builtin_amdgcn_cosf(ang), sn = __builtin_amdgcn_sinf(ang);
                ore[e] = re * cs + im * sn; oim[e] = im * cs - re * sn; }
            bf16_t* o = t1 + ((size_t)(((b * 4 + g) * 128 + c) * 2) * 64 + k1) * 128 + n2_0 + 32 * a2 + 8 * fq;
            u32x4 w; w.x = pk2(ore[0], ore[1]); w.y = pk2(ore[2], ore[3]); w.z = pk2(ore[4], ore[5]); w.w = pk2(ore[6], ore[7]);
            *(u32x4*)o = w;
            w.x = pk2(oim[0], oim[1]); w.y = pk2(oim[2], oim[3]); w.z = pk2(oim[4], oim[5]); w.w = pk2(oim[6], oim[7]);
            *(u32x4*)(o + 64 * 128) = w; }
    }
}
DI void fft2_item(const bf16_t* t1, bf16_t* y, const LAS unsigned char* cb, int item, int lane) {
    const int chh = item & 1, k1 = (item >> 1) & 63, g = (item >> 7) & 3, b = item >> 9;
    const int fr = lane & 15, fq = lane >> 4;
#pragma unroll 1
    for (int a2 = 0; a2 < 2; ++a2) {
        f32x4 acc[2][8];
#pragma unroll
        for (int mt = 0; mt < 2; ++mt)
#pragma unroll
            for (int nt = 0; nt < 8; ++nt) acc[mt][nt] = (f32x4){0.f, 0.f, 0.f, 0.f};
#pragma unroll
        for (int kh = 0; kh < 2; ++kh) {
            bf16x8 a[4][2];
#pragma unroll
            for (int kq = 0; kq < 4; ++kq) { const int n2_0 = 32 * kq + 8 * fq;
#pragma unroll
                for (int mt = 0; mt < 2; ++mt) { const int c = 64 * chh + 32 * a2 + 8 * (fr >> 2) + 4 * mt + (fr & 3);
                    a[kq][mt] = *(const bf16x8*)(t1 + ((size_t)((((b * 4 + g) * 128 + c) * 2 + kh) * 64 + k1)) * 128 + n2_0); } }
#pragma unroll
            for (int kq = 0; kq < 4; ++kq)
#pragma unroll
                for (int nt = 0; nt < 8; ++nt) { const bf16x8 bf = *(const LAS bf16x8*)(cb + (((kh * 4 + kq) * 8 + nt) * 64 + lane) * 16);
#pragma unroll
                    for (int mt = 0; mt < 2; ++mt) acc[mt][nt] = MFMA16(a[kq][mt], bf, acc[mt][nt]);
                    if (nt == 7) asm volatile("" ::: "memory"); }
        }
#pragma unroll
        for (int nt = 0; nt < 8; ++nt) { const int k2 = 16 * nt + fr; const size_t tok = (size_t)b * 8192 + k1 + 64 * k2;
            const f32x4 v0 = acc[0][nt], v1 = acc[1][nt];
            u32x4 w; w.x = pk2(v0[0], v0[1]); w.y = pk2(v0[2], v0[3]); w.z = pk2(v1[0], v1[1]); w.w = pk2(v1[2], v1[3]);
            *(u32x4*)(y + tok * 512 + g * 128 + 64 * chh + 32 * a2 + 8 * fq) = w; }
    }
}

DI void dma16(const void* gsrc, LAS unsigned char* lds_wave_base) { __builtin_amdgcn_global_load_lds((const unsigned*)gsrc, (LAS unsigned*)lds_wave_base, 16, 0, 0); }
constexpr int NA_KOFF = 0, NA_VOFF = 57344, NA_RPB = 114688, NA_UNITS = 2048;
struct NaUnit { int b, h, s, chf, rb, kc0; };
DI NaUnit na_decode(int uid) { NaUnit u; u.chf = uid & 1; u.s = (uid >> 1) & 31; u.h = (uid >> 6) & 7; u.b = uid >> 9; u.rb = min(max(4 * u.s - 4, 0), 120); u.kc0 = u.chf ? 24 : 0; return u; }
DI void na_stage_k(const NaUnit& u, const bf16_t* k, LAS unsigned char* lds, int wave, int lane) {
    for (int p = wave; p < 55; p += 8) { const int P = p * 64 + lane, j = P / 320, rem = P - j * 320, kl = rem >> 3, cpos = rem & 7, chunk = cpos ^ ((kl >> 1) & 7);
        const int row = min(u.rb + j, 127);
        dma16(k + ((size_t)u.b * 8192 + row * 64 + u.kc0 + kl) * 512 + u.h * 64 + 8 * chunk, lds + NA_KOFF + p * 1024); }
}
DI void na_stage_v(const NaUnit& u, const bf16_t* vt, LAS unsigned char* lds, int wave, int lane) {
    for (int p = wave; p < 55; p += 8) { const int P = p * 64 + lane, rowid = P / 5, c5 = P - rowid * 5, j = rowid >> 6, d = rowid & 63;
        const int row = min(u.rb + j, 127);
        dma16(vt + (size_t)(u.b * 512 + u.h * 64 + d) * 8192 + row * 64 + u.kc0 + 8 * c5, lds + NA_VOFF + p * 1024); }
}
DI void na_phase(const Frame& F, const bf16_t* q, const bf16_t* k, const bf16_t* vt, bf16_t* o) {
    LAS unsigned char* lds = F.lds; const LAS float* rpbl = (const LAS float*)(F.lds + NA_RPB);
    const int lane = F.lane, w = F.wave, fr = lane & 15, fq = lane >> 4;
    int uid = F.vcu;
    if (uid >= NA_UNITS) return;
    NaUnit u = na_decode(uid);
    na_stage_k(u, k, lds, w, lane);
    VM_WAIT(); __syncthreads();
    for (;;) {
        na_stage_v(u, vt, lds, w, lane);
        const int r = 4 * u.s + (w >> 1), jb = 2 * u.chf + (w & 1);
        const int rs = min(max(r - 4, 0), 120), j0 = rs - u.rb;
        const int w0 = jb == 0 ? 0 : (jb == 1 ? 8 : (jb == 2 ? 24 : 32)), wl = w0 - u.kc0;
        const size_t tokq = (size_t)u.b * 8192 + r * 64 + 16 * jb + fr;
        bf16x8 qf[2];
#pragma unroll
        for (int ks = 0; ks < 2; ++ks) qf[ks] = *(const bf16x8*)(q + tokq * 512 + u.h * 64 + 32 * ks + 8 * fq);
        f32x4 s[8][2];
#pragma unroll
        for (int i = 0; i < 8; ++i)
#pragma unroll
            for (int ch = 0; ch < 2; ++ch) { const int kl = wl + 16 * ch + fr, sw = (kl >> 1) & 7;
                const LAS unsigned char* kb = lds + NA_KOFF + ((j0 + i) * 40 + kl) * 128;
                const bf16x8 k0 = *(const LAS bf16x8*)(kb + ((fq ^ sw) * 16)), k1 = *(const LAS bf16x8*)(kb + (((4 + fq) ^ sw) * 16));
                f32x4 z = (f32x4){0.f, 0.f, 0.f, 0.f};
                z = MFMA16(k0, qf[0], z); s[i][ch] = MFMA16(k1, qf[1], z); }
        const int c = 16 * jb + fr, cs = min(max(c - 8, 0), 48);
        float mx = -1e30f;
#pragma unroll
        for (int i = 0; i < 8; ++i) { const LAS float* brow = rpbl + u.h * 480 + (rs + i - r + 7) * 32;
#pragma unroll
            for (int ch = 0; ch < 2; ++ch)
#pragma unroll
                for (int rr = 0; rr < 4; ++rr) { const int kc = w0 + 16 * ch + 4 * fq + rr; const bool valid = (kc >= cs) && (kc < cs + 16);
                    const int dc = valid ? (kc - c + 15) : 0;
                    const float v = valid ? s[i][ch][rr] + brow[dc] : -1e30f; s[i][ch][rr] = v; mx = fmaxf(mx, v); } }
        mx = fmaxf(mx, __shfl_xor(mx, 16)); mx = fmaxf(mx, __shfl_xor(mx, 32));
        float l = 0.f;
        u32x4 pw[8];
#pragma unroll
        for (int i = 0; i < 8; ++i) { float p[8];
#pragma unroll
            for (int ch = 0; ch < 2; ++ch)
#pragma unroll
                for (int rr = 0; rr < 4; ++rr) { p[4 * ch + rr] = __builtin_amdgcn_exp2f((s[i][ch][rr] - mx) * 1.4426950408889634f); l += p[4 * ch + rr]; }
            pw[i].x = pk2(p[0], p[1]); pw[i].y = pk2(p[2], p[3]); pw[i].z = pk2(p[4], p[5]); pw[i].w = pk2(p[6], p[7]); }
        l += __shfl_xor(l, 16); l += __shfl_xor(l, 32);
        const float inv = 1.0f / l;
        VM_WAIT(); __syncthreads();
        const int nuid = uid + F.G; const bool has_next = nuid < NA_UNITS;
        NaUnit nu = u;
        if (has_next) { nu = na_decode(nuid); na_stage_k(nu, k, lds, w, lane); }
        f32x4 oacc[4];
#pragma unroll
        for (int dt = 0; dt < 4; ++dt) oacc[dt] = (f32x4){0.f, 0.f, 0.f, 0.f};
#pragma unroll
        for (int i = 0; i < 8; ++i) { const bf16x8 pf = __builtin_bit_cast(bf16x8, pw[i]);
#pragma unroll
            for (int dt = 0; dt < 4; ++dt) { const LAS unsigned char* vb = lds + NA_VOFF + ((j0 + i) * 64 + 16 * dt + fr) * 80 + (wl + 4 * fq) * 2;
                const u32x2 lo = *(const LAS u32x2*)vb, hi = *(const LAS u32x2*)(vb + 32);
                u32x4 vw; vw.x = lo.x; vw.y = lo.y; vw.z = hi.x; vw.w = hi.y;
                oacc[dt] = MFMA16(__builtin_bit_cast(bf16x8, vw), pf, oacc[dt]); } }
#pragma unroll
        for (int dt = 0; dt < 4; ++dt) { u32x2 wv; wv.x = pk2(oacc[dt][0] * inv, oacc[dt][1] * inv); wv.y = pk2(oacc[dt][2] * inv, oacc[dt][3] * inv);
            *(u32x2*)(o + tokq * 512 + u.h * 64 + 16 * dt + 4 * fq) = wv; }
        VM_WAIT(); __syncthreads();
        if (!has_next) break;
        uid = nuid; u = nu;
    }
}
DI void mem_phase(const Frame& F, const bf16_t* qm, const bf16_t* km, const bf16_t* vtm, bf16_t* o) {
    LAS unsigned char* lds = F.lds; const int lane = F.lane, w = F.wave, fr = lane & 15, fq = lane >> 4;
    for (int chunk = F.vcu; chunk < 256; chunk += F.G) {
        const int pair = chunk >> 4, b = pair >> 2, h = pair & 3, qc = chunk & 15;
        for (int i = 0; i < 8; ++i) { const int p = w + 8 * i, P = p * 64 + lane;
            { const int key = P >> 4, cpos = P & 15, c = cpos ^ (key & 15); dma16(km + (size_t)(b * 256 + key) * 512 + h * 128 + 8 * c, lds + p * 1024); }
            { const int d = P >> 5, cpos = P & 31, c = cpos ^ (d & 15); dma16(vtm + (size_t)(b * 512 + h * 128 + d) * 256 + 8 * c, lds + 65536 + p * 1024); } }
        VM_WAIT(); __syncthreads();
#pragma unroll 1
        for (int pass = 0; pass < 4; ++pass) {
            asm volatile("" ::: "memory");
            const size_t tokq = (size_t)b * 8192 + qc * 512 + w * 64 + pass * 16 + fr;
            bf16x8 qf[4];
#pragma unroll
            for (int ks = 0; ks < 4; ++ks) qf[ks] = *(const bf16x8*)(qm + tokq * 512 + h * 128 + 32 * ks + 8 * fq);
            f32x4 s[16];
#pragma unroll
            for (int kt = 0; kt < 16; ++kt) { const LAS unsigned char* kb = lds + (16 * kt + fr) * 256;
                f32x4 z0 = (f32x4){0.f, 0.f, 0.f, 0.f};
#pragma unroll
                for (int ks = 0; ks < 4; ++ks) { const bf16x8 kf = *(const LAS bf16x8*)(kb + (((4 * ks + fq) ^ fr) * 16)); z0 = MFMA16(kf, qf[ks], z0); }
                s[kt] = z0; if ((kt & 3) == 3) asm volatile("" ::: "memory"); }
            u32x4 pw[8];
            float mx = -1e30f;
#pragma unroll
            for (int kt = 0; kt < 16; ++kt)
#pragma unroll
                for (int rr = 0; rr < 4; ++rr) mx = fmaxf(mx, s[kt][rr]);
            mx = fmaxf(mx, __shfl_xor(mx, 16)); mx = fmaxf(mx, __shfl_xor(mx, 32));
            float l = 0.f;
#pragma unroll
            for (int u = 0; u < 8; ++u) { float p[8];
#pragma unroll
                for (int e = 0; e < 8; ++e) { p[e] = __builtin_amdgcn_exp2f((s[2 * u + (e >> 2)][e & 3] - mx) * 1.4426950408889634f); l += p[e]; }
                pw[u].x = pk2(p[0], p[1]); pw[u].y = pk2(p[2], p[3]); pw[u].z = pk2(p[4], p[5]); pw[u].w = pk2(p[6], p[7]); }
            l += __shfl_xor(l, 16); l += __shfl_xor(l, 32);
            const float inv = 1.0f / l;
            f32x4 oacc[8];
#pragma unroll
            for (int dt = 0; dt < 8; ++dt) oacc[dt] = (f32x4){0.f, 0.f, 0.f, 0.f};
#pragma unroll
            for (int u = 0; u < 8; ++u)
#pragma unroll
                for (int dt = 0; dt < 8; ++dt) { const LAS unsigned char* vb = lds + 65536 + (16 * dt + fr) * 512;
                    const u32x2 lo = *(const LAS u32x2*)(vb + (((8 * u + fq) ^ (fr << 1)) * 8)), hi = *(const LAS u32x2*)(vb + (((8 * u + 4 + fq) ^ (fr << 1)) * 8));
                    u32x4 vw; vw.x = lo.x; vw.y = lo.y; vw.z = hi.x; vw.w = hi.y;
                    oacc[dt] = MFMA16(__builtin_bit_cast(bf16x8, vw), __builtin_bit_cast(bf16x8, pw[u]), oacc[dt]);
                    if (dt == 7) asm volatile("" ::: "memory"); }
#pragma unroll
            for (int dt = 0; dt < 8; ++dt) { u32x2 wv; wv.x = pk2(oacc[dt][0] * inv, oacc[dt][1] * inv); wv.y = pk2(oacc[dt][2] * inv, oacc[dt][3] * inv);
                *(u32x2*)(o + tokq * 512 + h * 128 + 16 * dt + 4 * fq) = wv; }
        }
        __syncthreads();
    }
}

DI void p6_ln_router(const Frame& F, const Args& a) {
    unsigned char* ws = F.ws; const int lane = F.lane, w = F.wave, fr = lane & 15, fq = lane >> 4;
    const float* v = (const float*)(ws + WS_V); bf16_t* h = (bf16_t*)(ws + WS_H); const bf16_t* wrt = (const bf16_t*)(ws + WS_WRT);
    unsigned* gcnt = (unsigned*)(ws + WS_CTL) + CW_GCNT; int* list = (int*)(ws + WS_LIST); unsigned* rec = (unsigned*)(ws + WS_REC);
    LAS float* lg = (LAS float*)(F.lds + w * 5120);
    LAS int* hist = (LAS int*)(F.lds + MISC_OFF + MS_HIST); LAS int* base = (LAS int*)(F.lds + MISC_OFF + MS_BASE);
    const float* g1 = a.in[IN_LN1G]; const float* b1 = a.in[IN_LN1B];
    f32x4 gv[4], bv[4];
#pragma unroll
    for (int j = 0; j < 4; ++j) { gv[j] = *(const f32x4*)(g1 + 4 * lane + 256 * j); bv[j] = *(const f32x4*)(b1 + 4 * lane + 256 * j); }
    for (int chunk = F.vcu; chunk < T / 128; chunk += F.G) {
        const int tok0 = chunk * 128 + 16 * w;
        if (F.tid < 64) hist[F.tid] = 0;
        for (int rr = 0; rr < 16; ++rr) { const size_t row = (size_t)(tok0 + rr);
            f32x4 x[4]; float s = 0.f;
#pragma unroll
            for (int j = 0; j < 4; ++j) { x[j] = *(const f32x4*)(v + row * 1024 + 4 * lane + 256 * j); s += (x[j][0] + x[j][1]) + (x[j][2] + x[j][3]); }
            const float mean = wave_sum(s) * (1.0f / 1024.0f); float s2 = 0.f;
#pragma unroll
            for (int j = 0; j < 4; ++j) { x[j] = x[j] - mean; s2 += (x[j][0] * x[j][0] + x[j][1] * x[j][1]) + (x[j][2] * x[j][2] + x[j][3] * x[j][3]); }
            const float rstd = 1.0f / sqrtf(wave_sum(s2) * (1.0f / 1024.0f) + LN_EPS);
#pragma unroll
            for (int j = 0; j < 4; ++j) { const f32x4 y = x[j] * rstd * gv[j] + bv[j]; u32x2 o; o.x = pk2(y[0], y[1]); o.y = pk2(y[2], y[3]);
                *(u32x2*)(h + row * 1024 + 4 * lane + 256 * j) = o; } }
        __syncthreads();
        f32x4 acc[5];
#pragma unroll
        for (int mt = 0; mt < 5; ++mt) acc[mt] = (f32x4){0.f, 0.f, 0.f, 0.f};
        const bf16_t* hb = h + (size_t)(tok0 + fr) * 1024 + 8 * fq; const bf16_t* wb = wrt + (size_t)fr * 1024 + 8 * fq;
#pragma unroll 4
        for (int ks = 0; ks < 32; ++ks) { const bf16x8 bfr = *(const bf16x8*)(hb + 32 * ks);
#pragma unroll
            for (int mt = 0; mt < 5; ++mt) acc[mt] = MFMA16(*(const bf16x8*)(wb + (size_t)mt * 16 * 1024 + 32 * ks), bfr, acc[mt]); }
#pragma unroll
        for (int mt = 0; mt < 5; ++mt)
#pragma unroll
            for (int rr = 0; rr < 4; ++rr) lg[fr * 80 + 16 * mt + 4 * fq + rr] = acc[mt][rr];
        LDS_WAIT(); asm volatile("" ::: "memory");
        int e1 = 0, e2 = 0, l1 = 0, l2 = 0; float w1 = 0.f, w2 = 0.f;
        if (lane < 16) {
            const LAS float* L = lg + lane * 80;
            float gl[8]; int gi = 0; float gm;
#pragma unroll
            for (int j = 0; j < 8; ++j) gl[j] = L[64 + j] + a.in[IN_BRG][j];
            gm = gl[0];
#pragma unroll
            for (int j = 1; j < 8; ++j) if (gl[j] > gm) { gm = gl[j]; gi = j; }
            float se = 0.f;
#pragma unroll
            for (int j = 0; j < 8; ++j) se += __expf(gl[j] - gm);
            const float pg = 1.0f / se;
            float el[8];
#pragma unroll
            for (int j = 0; j < 8; ++j) el[j] = L[gi * 8 + j] + a.in[IN_BRE][gi * 8 + j];
            int i1 = 0; float v1 = el[0];
#pragma unroll
            for (int j = 1; j < 8; ++j) if (el[j] > v1) { v1 = el[j]; i1 = j; }
            int i2 = -1; float v2 = -3.0e38f;
#pragma unroll
            for (int j = 0; j < 8; ++j) if (j != i1 && el[j] > v2) { v2 = el[j]; i2 = j; }
            const float t = __expf(v2 - v1); const float p1 = 1.0f / (1.0f + t);
            w1 = p1 * pg; w2 = (t * p1) * pg; e1 = gi * 8 + i1; e2 = gi * 8 + i2;
            l1 = __hip_atomic_fetch_add(&hist[e1], 1, __ATOMIC_RELAXED, __HIP_MEMORY_SCOPE_WORKGROUP); l2 = __hip_atomic_fetch_add(&hist[e2], 1, __ATOMIC_RELAXED, __HIP_MEMORY_SCOPE_WORKGROUP);
        }
        __syncthreads();
        if (F.tid < 64) { const int c = hist[F.tid]; base[F.tid] = c > 0 ? (int)atomicAdd(gcnt + F.tid, (unsigned)c) : 0; }
        __syncthreads();
        if (lane < 16) { const int tok = tok0 + lane; const int s1 = base[e1] + l1, s2 = base[e2] + l2;
            if (s1 < LIST_CAP) list[(size_t)e1 * LIST_CAP + s1] = tok;
            if (s2 < LIST_CAP) list[(size_t)e2 * LIST_CAP + s2] = tok;
            u32x4 r0; r0.x = (unsigned)e1; r0.y = (unsigned)s1; r0.z = (unsigned)e2; r0.w = (unsigned)s2;
            *(u32x4*)(rec + (size_t)tok * 8) = r0;
            u32x2 r1; r1.x = __float_as_uint(w1); r1.y = __float_as_uint(w2); *(u32x2*)(rec + (size_t)tok * 8 + 4) = r1; }
        __syncthreads();
    }
}

DI void p9_combine(const Frame& F, const Args& a) {
    unsigned char* ws = F.ws; const int lane = F.lane;
    const bf16_t* h = (const bf16_t*)(ws + WS_H); const bf16_t* yb = (const bf16_t*)(ws + WS_YB); const unsigned* rec = (const unsigned*)(ws + WS_REC);
    const LAS int* tstart = (const LAS int*)(F.lds + MISC_OFF + MS_TSTART);
    f32x4 gv[4], bv[4];
#pragma unroll
    for (int j = 0; j < 4; ++j) { gv[j] = *(const f32x4*)(a.in[IN_LN2G] + 4 * lane + 256 * j); bv[j] = *(const f32x4*)(a.in[IN_LN2B] + 4 * lane + 256 * j); }
    const int gw = F.vcu * 8 + F.wave, NGW = F.G * 8;
    for (int t = gw; t < T; t += NGW) {
        const u32x4 r0 = *(const u32x4*)(rec + (size_t)t * 8); const u32x2 r1 = *(const u32x2*)(rec + (size_t)t * 8 + 4);
        const size_t row1 = (size_t)tstart[r0.x] * 256 + r0.y, row2 = (size_t)tstart[r0.z] * 256 + r0.w;
        const float w1 = __uint_as_float(r1.x), w2 = __uint_as_float(r1.y);
        f32x4 x[4]; float s = 0.f;
#pragma unroll
        for (int j = 0; j < 4; ++j) { const int col = 4 * lane + 256 * j;
            const u32x2 hv = *(const u32x2*)(h + (size_t)t * 1024 + col), y1 = *(const u32x2*)(yb + row1 * 1024 + col), y2 = *(const u32x2*)(yb + row2 * 1024 + col);
            x[j][0] = ALPHA * bf_lo(hv.x) + w1 * bf_lo(y1.x) + w2 * bf_lo(y2.x); x[j][1] = ALPHA * bf_hi(hv.x) + w1 * bf_hi(y1.x) + w2 * bf_hi(y2.x);
            x[j][2] = ALPHA * bf_lo(hv.y) + w1 * bf_lo(y1.y) + w2 * bf_lo(y2.y); x[j][3] = ALPHA * bf_hi(hv.y) + w1 * bf_hi(y1.y) + w2 * bf_hi(y2.y);
            s += (x[j][0] + x[j][1]) + (x[j][2] + x[j][3]); }
        const float mean = wave_sum(s) * (1.0f / 1024.0f); float s2 = 0.f;
#pragma unroll
        for (int j = 0; j < 4; ++j) { x[j] = x[j] - mean; s2 += (x[j][0] * x[j][0] + x[j][1] * x[j][1]) + (x[j][2] * x[j][2] + x[j][3] * x[j][3]); }
        const float rstd = 1.0f / sqrtf(wave_sum(s2) * (1.0f / 1024.0f) + LN_EPS);
#pragma unroll
        for (int j = 0; j < 4; ++j) *(f32x4*)(a.out + (size_t)t * 1024 + 4 * lane + 256 * j) = x[j] * rstd * gv[j] + bv[j];
    }
}

constexpr int N_PHASES = 11;
__global__ void __launch_bounds__(512, 2) mk_fwd(Args args) {
    extern __shared__ __attribute__((aligned(16))) unsigned char lds_raw[];
    Frame F;
    F.lds = (LAS unsigned char*)lds_raw;
    F.tid = threadIdx.x; F.lane = F.tid & 63; F.wave = __builtin_amdgcn_readfirstlane(F.tid >> 6);
    F.G = gridDim.x; { const int bx = blockIdx.x; F.vcu = (F.G % 8 == 0) ? (bx % 8) * (F.G / 8) + bx / 8 : bx; }
    F.ws = args.ws;
    unsigned char* ws = args.ws;
    for (int u = F.tid; u < (LDS_BYTES - MISC_OFF) / 4; u += 512) ((LAS unsigned*)(F.lds + MISC_OFF))[u] = 0u;
    __syncthreads();
    const int lo = args.ph_lo, hi = args.ph_hi;
    XcdBarrier bar; bar.bar = (unsigned*)(ws + WS_CTL) + CW_BAR; bar.x = 0; bar.st = nullptr;
    if (hi - lo > 1) bar = xcd_barrier_post((unsigned*)(ws + WS_CTL) + CW_BAR, (volatile LAS unsigned*)(F.lds + MISC_OFF + MS_BAR));
#ifndef PH_MASK
#define PH_MASK 0xffff
#endif
#ifndef PROBE_TWICE
#define PROBE_TWICE -1
#endif
#define IN(k) (((PH_MASK >> (k)) & 1) && lo <= (k) && (k) < hi)
#define REP(k) for (int rep_ = 0; rep_ < ((k) == PROBE_TWICE ? 2 : 1); ++rep_)
#define SEAM(k) do { if (IN(k) && IN((k) + 1)) xcd_barrier(bar); } while (0)
    const int cid = (int)blockIdx.x;

    if (IN(0)) REP(0) { p0_prologue(F, args); }
    SEAM(0);
    if (IN(1)) REP(1) {
        { SchedP1F S{1024, F.G, cid, (const char*)(ws + WS_XB), (const char*)(ws + WS_W1T)}; EpiP1<false> E{ws, args.in[IN_BGATE]};
          pg8::gemm_phase<EpiP1<false>, SchedP1F>(F.lds, S, E); }
        { SchedP1g S{1024, F.G, cid, (const char*)(ws + WS_XB), (const char*)(ws + WS_W1T)}; EpiP1<true> E{ws, args.in[IN_BGATE]};
          pg8::gemm_phase<EpiP1<true>, SchedP1g>(F.lds, S, E); }
        { SchedP1a S{1024, F.G, cid, (const char*)(ws + WS_XB), (const char*)(ws + WS_W1T), (const char*)(ws + WS_MEMB), (const char*)(ws + WS_WKVT)}; EpiP1<false> E{ws, args.in[IN_BGATE]};
          pg8::gemm_phase<EpiP1<false>, SchedP1a>(F.lds, S, E); }
    }
    SEAM(1);
    if (IN(2)) REP(2) {
        __syncthreads();
        const int gw = F.vcu * 8 + F.wave, NGW = F.G * 8;
        { LAS unsigned char* fb = F.lds;
          for (int i = F.tid; i < 2048; i += 512) *(LAS u32x4*)(fb + i * 16) = *(const u32x4*)(ws + WS_F64 + (size_t)i * 16);
          __syncthreads();
          for (int it = gw; it < 4096; it += NGW) fft1_item((const bf16_t*)(ws + WS_ZT), (bf16_t*)(ws + WS_T1), fb, it, F.lane);
          __syncthreads(); }
        { LAS float* rpbl = (LAS float*)(F.lds + NA_RPB);
          for (int i = F.tid; i < 8 * 15 * 32; i += 512) { const int dc = i & 31, dr = (i >> 5) % 15, hh = i / 480; rpbl[i] = dc < 31 ? args.in[IN_RPB][(hh * 15 + dr) * 31 + dc] : 0.f; }
          __syncthreads();
          na_phase(F, (const bf16_t*)(ws + WS_Q), (const bf16_t*)(ws + WS_K), (const bf16_t*)(ws + WS_VT), (bf16_t*)(ws + WS_ONA)); }
        mem_phase(F, (const bf16_t*)(ws + WS_QM), (const bf16_t*)(ws + WS_KVM), (const bf16_t*)(ws + WS_KVM + MiB), (bf16_t*)(ws + WS_OMEM));
    }
    SEAM(2);
    if (IN(3)) REP(3) {
        LAS unsigned char* cb = F.lds;
        for (int i = F.tid; i < 4096; i += 512) *(LAS u32x4*)(cb + i * 16) = *(const u32x4*)(ws + WS_C128 + (size_t)i * 16);
        __syncthreads();
        const int gw = F.vcu * 8 + F.wave, NGW = F.G * 8;
        for (int it = gw; it < 2048; it += NGW) fft2_item((const bf16_t*)(ws + WS_T1), (bf16_t*)(ws + WS_Y), cb, it, F.lane);
        __syncthreads();
    }
    SEAM(3);
    if (IN(4)) REP(4) {
        SchedMerge S{512, F.G, cid, (const char*)(ws + WS_Y), (const char*)(ws + WS_WFOT)};
        EpiMerge E{(const bf16_t*)(ws + WS_GATES), (bf16_t*)(ws + WS_MERGED)};
        pg8::gemm_phase<EpiMerge, SchedMerge>(F.lds, S, E);
    }
    SEAM(4);
    if (IN(5)) REP(5) { p_expert_cvt(F, args); }
    SEAM(5);
    if (IN(6)) REP(6) {
        SchedOut S{1024, F.G, cid, (const char*)(ws + WS_MERGED), (const char*)(ws + WS_WOUTT)}; EpiOut E{args.in[IN_X], (float*)(ws + WS_V)};
        pg8::gemm_phase<EpiOut, SchedOut>(F.lds, S, E);
    }
    SEAM(6);
    if (IN(7)) { p6_ln_router(F, args); }
    SEAM(7);
    if (IN(8)) REP(8) {
        moe_tables(F);
        SchedMoeGU S{1024, F.G, cid, (const char*)(ws + WS_H), (const char*)(ws + WS_WGUT), (const int*)(ws + WS_LIST), F.lds + MISC_OFF}; EpiSwiGLU E{(bf16_t*)(ws + WS_HMOE)};
        pg8::gemm_phase<EpiSwiGLU, SchedMoeGU>(F.lds, S, E);
    }
    SEAM(8);
    if (IN(9)) REP(9) {
        moe_tables(F);
        SchedMoeD S{512, F.G, cid, (const char*)(ws + WS_HMOE), (const char*)(ws + WS_WDT), F.lds + MISC_OFF}; EpiDown E{(bf16_t*)(ws + WS_YB)};
        pg8::gemm_phase<EpiDown, SchedMoeD>(F.lds, S, E);
    }
    SEAM(9);
    if (IN(10)) REP(10) { moe_tables(F); p9_combine(F, args); }
#undef IN
#undef SEAM
#undef REP
}

#ifndef MK_PER_PHASE
#define MK_PER_PHASE 0
#endif
extern "C" void kernel_launch(void* const* d_in, const int* in_sizes, int n_in, void* d_out, int out_size, void* d_ws, size_t ws_size, hipStream_t stream) {
    static int grid = 0;
    if (grid == 0) {
        if (n_in != 22 || in_sizes[0] != T * DM || out_size != T * DM || ws_size < WS_END) {
            fprintf(stderr, "kernel_launch: unexpected problem (n_in %d, in0 %d, out %d, ws %zu < %zu); nothing launched\n", n_in, n_in > 0 ? in_sizes[0] : -1, out_size, ws_size, (size_t)WS_END); grid = -1; return; }
        int dev = 0, cus = 0, per_cu = 0;
        if (hipGetDevice(&dev) != hipSuccess || hipDeviceGetAttribute(&cus, hipDeviceAttributeMultiprocessorCount, dev) != hipSuccess) { grid = -1; return; }
        if (hipFuncSetAttribute((const void*)mk_fwd, hipFuncAttributeMaxDynamicSharedMemorySize, LDS_BYTES) != hipSuccess) { fprintf(stderr, "kernel_launch: hipFuncSetAttribute failed\n"); grid = -1; return; }
        if (hipOccupancyMaxActiveBlocksPerMultiprocessor(&per_cu, (const void*)mk_fwd, 512, LDS_BYTES) != hipSuccess || per_cu < 1)
            fprintf(stderr, "kernel_launch: occupancy query reports %d workgroups per CU\n", per_cu);
        (void)hipGetLastError();
        grid = cus;
    }
    if (grid < 0) return;
    if (hipMemsetAsync((char*)d_ws + WS_CTL, 0, CTL_ZERO_BYTES, stream) != hipSuccess) return;
    Args a{};
    for (int i = 0; i < 22; ++i) a.in[i] = (const float*)d_in[i];
    a.out = (float*)d_out; a.ws = (unsigned char*)d_ws;
#if MK_PER_PHASE
    for (int p = 0; p < N_PHASES; ++p) { a.ph_lo = p; a.ph_hi = p + 1; hipLaunchKernelGGL(mk_fwd, dim3(grid), dim3(512), LDS_BYTES, stream, a); }
#else
    a.ph_lo = 0; a.ph_hi = N_PHASES; hipLaunchKernelGGL(mk_fwd, dim3(grid), dim3(512), LDS_BYTES, stream, a);
#endif
}
```

```cpp
#include <hip/hip_runtime.h>
#include <cstdio>
#include <cstdint>

#define DI __device__ __forceinline__
#ifndef PROBE_BLOCK
#define PROBE_BLOCK 37
#endif
#ifndef PROBE_SCALE
#define PROBE_SCALE 1
#endif
#define LAS __attribute__((address_space(3)))
#define GAS __attribute__((address_space(1)))
typedef unsigned short bf16_t;
typedef short bf16x8 __attribute__((ext_vector_type(8)));
typedef float f32x4 __attribute__((ext_vector_type(4)));
typedef float f32x2 __attribute__((ext_vector_type(2)));
typedef unsigned u32x4 __attribute__((ext_vector_type(4)));
typedef unsigned u32x2 __attribute__((ext_vector_type(2)));

constexpr int T = 32768, DM = 1024, NBATCH = 4, SEQ = 8192, MEML = 256;
constexpr int NEXP = 64, DEXP = 512;
constexpr float ALPHA = 1.189207115002721f;
constexpr float LN_EPS = 1e-5f;
constexpr int LIST_CAP = 32768;

constexpr size_t MiB = 1u << 20;
constexpr size_t WS_CTL = 0, CTL_ZERO_BYTES = 64 * 1024;
constexpr size_t WS_W1T = 1 * MiB;
constexpr size_t WS_WKVT = 13 * MiB;
constexpr size_t WS_WFOT = 15 * MiB, WS_WNAT = 16 * MiB, WS_WMOT = 17 * MiB;
constexpr size_t WS_WOUTT = 18 * MiB;
constexpr size_t WS_WRT = 20 * MiB;
constexpr size_t WS_F64 = 20 * MiB + 256 * 1024;
constexpr size_t WS_C128 = 20 * MiB + 320 * 1024;
constexpr size_t WS_LIST = 21 * MiB;
constexpr size_t WS_REC = 29 * MiB;
constexpr size_t WS_R1 = 30 * MiB;
constexpr size_t WS_R2 = 94 * MiB;
constexpr size_t WS_R3 = 158 * MiB;
constexpr size_t WS_R4 = 222 * MiB;
constexpr size_t WS_R5 = 286 * MiB;
constexpr size_t WS_R6 = 350 * MiB;
constexpr size_t WS_KVM = 542 * MiB;
constexpr size_t WS_MEMB = 544 * MiB;
constexpr size_t WS_END = 546 * MiB;
constexpr size_t WS_XB = WS_R1, WS_T1 = WS_R1, WS_H = WS_R1;
constexpr size_t WS_ZT = WS_R2, WS_Y = WS_R4 + 32 * MiB;
constexpr size_t WS_Q = WS_R3, WS_K = WS_R3 + 32 * MiB, WS_MERGED = WS_R3;
constexpr size_t WS_VT = WS_R4, WS_QM = WS_R4 + 32 * MiB;
constexpr size_t WS_ONA = WS_R5, WS_OMEM = WS_R5 + 32 * MiB;
constexpr size_t WS_GATES = WS_R6, WS_WGUT = WS_R6, WS_WDT = WS_R6 + 128 * MiB;
constexpr size_t WS_V = WS_R4;
constexpr size_t WS_HMOE = 270 * MiB;
constexpr size_t WS_YB = 94 * MiB;
constexpr int CW_BAR = 4096;
constexpr int CW_GCNT = 8192;
constexpr int CW_KVDONE = 8448;

constexpr int RING_BYTES = 131072;
constexpr int MISC_OFF = RING_BYTES;
constexpr int LDS_BYTES = 147456;
constexpr int MS_BAR = 0, MS_TSTART = 64, MS_CNT = 512, MS_TILEE = 1024, MS_HIST = 2048, MS_BASE = 2560;

DI unsigned pk2(float lo, float hi) {
    typedef __bf16 bf2 __attribute__((ext_vector_type(2)));
    f32x2 v = {lo, hi};
    bf2 r = __builtin_convertvector(v, bf2);
    return __builtin_bit_cast(unsigned, r);
}
DI size_t blk_off(int r, int c, int ncols) { return ((size_t)(r >> 4) * (ncols >> 5) + (c >> 5)) * 512 + (r & 15) * 32 + (c & 31); }
DI float bf_lo(unsigned w) { return __uint_as_float(w << 16); }
DI float bf_hi(unsigned w) { return __uint_as_float(w & 0xffff0000u); }
DI float wave_sum(float v) {
#pragma unroll
    for (int o = 1; o < 64; o <<= 1) v += __shfl_xor(v, o);
    return v;
}
DI float fast_sigmoid(float z) { return __builtin_amdgcn_rcpf(1.0f + __builtin_amdgcn_exp2f(-1.4426950408889634f * z)); }
#define LDS_WAIT() asm volatile("s_waitcnt lgkmcnt(0)" ::: "memory")
#define VM_WAIT() asm volatile("s_waitcnt vmcnt(0)" ::: "memory")

#define XB_TMO      128
#define XB_XCNT(j)  (256  + 64 * (j))
#define XB_XSUB(j)  (1280 + 64 * (j))
#define XB_XGEN(j)  (2304 + 64 * (j))
#define XB_TOP      3328
#define XB_TOPGEN   3392
#define XCD_BAR_WORDS 3456
#define XB_SPIN_CAP (1u << 18)

__device__ __forceinline__ unsigned xb_ld(unsigned* p)              { return __hip_atomic_load(p, __ATOMIC_RELAXED, __HIP_MEMORY_SCOPE_AGENT); }
__device__ __forceinline__ unsigned xb_add(unsigned* p, unsigned v) { return __hip_atomic_fetch_add(p, v, __ATOMIC_RELAXED, __HIP_MEMORY_SCOPE_AGENT); }
__device__ __forceinline__ unsigned xb_xcc_id() { return (unsigned)__builtin_amdgcn_s_getreg((3 << 11) | 20) & 0xFu; }
#define XB_SPIN(cond, bar) do { unsigned _sp = 0; while (cond) { __builtin_amdgcn_s_sleep(1); \
    if ((++_sp & 255u) == 0u) { if (xb_ld(&(bar)[XB_TMO])) break; if (_sp > XB_SPIN_CAP) { atomicAdd(&(bar)[XB_TMO], 1u); break; } } } } while (0)

struct XcdBarrier {
    unsigned* bar; unsigned x;
    volatile LAS unsigned* st;
};
__device__ __forceinline__ XcdBarrier xcd_barrier_post(unsigned* bar, volatile LAS unsigned* st) {
    XcdBarrier b; b.bar = bar; b.x = xb_xcc_id(); b.st = st;
    if (threadIdx.x == 0) (void)xb_add(&bar[XB_XCNT(b.x)], 1u);
    return b;
}
__device__ __forceinline__ void xcd_barrier_complete(unsigned* bar, unsigned x, unsigned& nloc, unsigned& nx) {
    const unsigned G = gridDim.x * gridDim.y * gridDim.z;
    unsigned sum, cnt, mine, sp = 0u;
    for (;;) {
        sum = 0u; cnt = 0u; mine = 0u;
#pragma unroll
        for (unsigned j = 0; j < 16; ++j) { const unsigned c = xb_ld(&bar[XB_XCNT(j)]); sum += c; cnt += (c > 0u) ? 1u : 0u; mine = (j == x) ? c : mine; }
        if (sum == G) break;
        __builtin_amdgcn_s_sleep(1);
        if ((++sp & 255u) == 0u) { if (xb_ld(&bar[XB_TMO])) break; if (sp > XB_SPIN_CAP) { atomicAdd(&bar[XB_TMO], 1u); break; } }
    }
    nloc = mine > 0u ? mine : 1u; nx = cnt > 0u ? cnt : 1u;
}
__device__ __forceinline__ void xcd_barrier(const XcdBarrier& b) {
    asm volatile("s_waitcnt vmcnt(0)" ::: "memory");
    __syncthreads();
    if (threadIdx.x == 0) {
        unsigned* bar = b.bar;
        __builtin_amdgcn_s_waitcnt(0);
        unsigned nloc = b.st[0], nx = b.st[1];
        if (nloc == 0u) { xcd_barrier_complete(bar, b.x, nloc, nx); b.st[0] = nloc; b.st[1] = nx; }
        const unsigned old = xb_add(&bar[XB_XSUB(b.x)], 1u);
        const unsigned gen = old / nloc;
        if (old + 1u == (gen + 1u) * nloc) {
            __builtin_amdgcn_fence(__ATOMIC_RELEASE, "agent");
            asm volatile("s_waitcnt vmcnt(0)" ::: "memory");
            const unsigned og = xb_add(&bar[XB_TOP], 1u);
            const unsigned tg = og / nx;
            if (og + 1u == (tg + 1u) * nx) xb_add(&bar[XB_TOPGEN], 1u);
            else XB_SPIN(xb_ld(&bar[XB_TOPGEN]) == tg, bar);
            __builtin_amdgcn_fence(__ATOMIC_ACQUIRE, "agent");
            xb_add(&bar[XB_XGEN(b.x)], 1u);
            asm volatile("s_waitcnt vmcnt(0)" ::: "memory");
        } else {
            XB_SPIN(xb_ld(&bar[XB_XGEN(b.x)]) == gen, bar);
            __builtin_amdgcn_fence(__ATOMIC_ACQUIRE, "agent");
            asm volatile("s_waitcnt vmcnt(0)" ::: "memory");
        }
    }
    __syncthreads();
}

namespace pg8 {
constexpr int BM = 256, BK = 64, HALF = 128, HTB = HALF * BK * 2, STAGE_BYTES = 8 * HTB;
DI int swz_s(int q) { return (0x78 >> (2 * q)) & 3; }
DI int lds_byte(int r, int c) { const int st = (r >> 4) * 2 + (c >> 5), rr = r & 15, cc = c & 31, ob = rr * 64 + cc * 2; return st * 1024 + (ob ^ (swz_s((ob >> 8) & 3) << 4)); }
DI void stage_rc(int b, int& R, int& C) { const int st = b / 1024, sb = b % 1024, swz = sb ^ (swz_s((sb >> 8) & 3) << 4); R = (st >> 1) * 16 + swz / 64; C = (st & 1) * 32 + (swz % 64) / 2; }
DI int perm32(int rho) { const int n = rho >> 4, i = rho & 15; return 8 * (i >> 2) + 4 * n + (i & 3); }

struct GU { const char* A; const char* B; int p0, p1, p2, p3; };
typedef f32x4 Acc[2][2][4][2];

DI unsigned off_plain(int r, int c, int K) { return (unsigned)(r * K + c) * 2u; }
DI unsigned off_blk(int r, int c, int K) { return (unsigned)(((r >> 4) * (K >> 5) + (c >> 5)) * 1024 + (r & 15) * 64 + (c & 31) * 2); }
DI void tile_order(int L, int nM, int nN, int& pm, int& pn) {
    const int nwg = nM * nN; int wgid = L;
    { const int q = nwg / 8, r = nwg % 8, xcd = wgid % 8, off = wgid / 8; wgid = (xcd < r ? xcd * (q + 1) : r * (q + 1) + (xcd - r) * q) + off; }
    const int nig = 8 * nN, gid = wgid / nig, fm = gid * 8, gsz = (nM - fm) < 8 ? (nM - fm) : 8;
    pm = fm + ((wgid % nig) % gsz); pn = (wgid % nig) / gsz;
}

template <class Epi, class Sched>
DI void gemm_phase(LAS unsigned char* lds, const Sched& S, const Epi& E) {
    const int tid = threadIdx.x, wid = __builtin_amdgcn_readfirstlane(tid >> 6), lane = tid & 63, wr = wid >> 2, wc = wid & 3, fr = lane & 15, fq = lane >> 4;
    const int K = S.K, nt = K / BK;
    int Rs[2], Cs[2];
    unsigned voffB[2], vA[2][2], nA_[2][2];
#pragma unroll
    for (int i = 0; i < 2; ++i) { stage_rc(tid * 16 + i * 8192, Rs[i], Cs[i]); const int Rb = Epi::PERM ? ((Rs[i] & ~31) + perm32(Rs[i] & 31)) : Rs[i];
        voffB[i] = S.voffB(Rb, Cs[i]);
        vA[0][i] = S.voffA(Rs[i], Cs[i]); vA[1][i] = vA[0][i] + S.hstepA(); nA_[0][i] = vA[0][i]; nA_[1][i] = vA[1][i]; }
    const size_t kstepA = S.kstepA(), kstepB = S.kstepB();
    const size_t hstepB = S.hstepB();
    const unsigned ldsw = (unsigned)wid * 1024u;
    const int aoff = lds_byte(wr * 64 + fr, fq * 8), boff = lds_byte(wc * 32 + fr, fq * 8);
#define PG8_SA(b, h) (((b) * 2 + (h)) * HTB)
#define PG8_SB(b, h) ((4 + (b) * 2 + (h)) * HTB)
#define PG8_STAGE2(bufoff, gbase, v0, v1) do { \
        __builtin_amdgcn_global_load_lds((const unsigned*)((const char*)(gbase) + (v0)), (LAS unsigned*)(lds + (bufoff) + ldsw), 16, 0, 0); \
        __builtin_amdgcn_global_load_lds((const unsigned*)((const char*)(gbase) + (v1)), (LAS unsigned*)(lds + (bufoff) + ldsw + 8192), 16, 0, 0); } while (0)
#define PG8_STAGEB(bufoff, gbase) PG8_STAGE2(bufoff, gbase, voffB[0], voffB[1])
#define PG8_LDA(dst, b, h) do { _Pragma("unroll") for (int m = 0; m < 4; ++m) _Pragma("unroll") for (int k = 0; k < 2; ++k) dst[m][k] = *(const LAS bf16x8*)(lds + PG8_SA(b, h) + aoff + m * 2048 + k * 1024); } while (0)
#define PG8_LDB(dst, b, h) do { _Pragma("unroll") for (int n = 0; n < 2; ++n) _Pragma("unroll") for (int k = 0; k < 2; ++k) dst[n][k] = *(const LAS bf16x8*)(lds + PG8_SB(b, h) + boff + n * 2048 + k * 1024); } while (0)
#define PG8_MMA(ai, bj, At, Bt) do { __builtin_amdgcn_s_setprio(1); _Pragma("unroll") for (int m = 0; m < 4; ++m) _Pragma("unroll") for (int n = 0; n < 2; ++n) _Pragma("unroll") for (int k = 0; k < 2; ++k) \
        acc[ai][bj][m][n] = __builtin_amdgcn_mfma_f32_16x16x32_bf16(Bt[n][k], At[m][k], acc[ai][bj][m][n], 0, 0, 0); __builtin_amdgcn_s_setprio(0); } while (0)
#define PG8_WAIT_V(n) asm volatile("s_waitcnt vmcnt(" #n ")" ::: "memory")
#define PG8_WAIT_L(n) asm volatile("s_waitcnt lgkmcnt(" #n ")" ::: "memory")
#define PG8_WAIT_VR(ns) asm volatile("s_cmp_lt_u32 %0, 8\n\ts_cbranch_scc1 .Lw8_%=\n\ts_cmp_lt_u32 %0, 16\n\ts_cbranch_scc1 .Lw16_%=\n\ts_cmp_lt_u32 %0, 32\n\ts_cbranch_scc1 .Lw24_%=\n\t" \
        "s_waitcnt vmcnt(40)\n\ts_branch .Lwd_%=\n.Lw24_%=:\n\ts_waitcnt vmcnt(24)\n\ts_branch .Lwd_%=\n.Lw16_%=:\n\ts_waitcnt vmcnt(16)\n\ts_branch .Lwd_%=\n.Lw8_%=:\n\ts_waitcnt vmcnt(8)\n.Lwd_%=:" :: "s"(ns) : "memory", "scc")
#define PG8_BAR __builtin_amdgcn_s_barrier()
#define PG8_SCHED __builtin_amdgcn_sched_barrier(0)
    GU cur, nxt; int ui = 0, ns_prev = 0;
    if (!S.next(0, cur)) return;
#ifdef PROBE_SEL
    unsigned long long pk_ = 0, pe_ = 0, pt0_ = __builtin_amdgcn_s_memrealtime(), pa_ = 0, pb_ = 0;
#define PSTAMP(x) do { if (Sched::PROBE) x = __builtin_amdgcn_s_memrealtime(); } while (0)
#else
#define PSTAMP(x) do { } while (0)
#endif
    Acc acc;
#pragma unroll
    for (int a = 0; a < 2; ++a)
#pragma unroll
        for (int b = 0; b < 2; ++b)
#pragma unroll
            for (int m = 0; m < 4; ++m)
#pragma unroll
                for (int n = 0; n < 2; ++n) acc[a][b][m][n] = (f32x4){0.f, 0.f, 0.f, 0.f};
    bf16x8 At[4][2], B0[2][2], B1[2][2];
    const char* cA = cur.A; const char* cB = cur.B;
    if constexpr (Sched::GATHER) {
#pragma unroll
        for (int i = 0; i < 2; ++i) { vA[0][i] = S.gatherA(cur, Rs[i], Cs[i]); vA[1][i] = S.gatherA(cur, Rs[i] + 128, Cs[i]); }
    }
    PG8_STAGEB(PG8_SB(0, 0), cB); PG8_STAGEB(PG8_SB(0, 1), cB + hstepB); PG8_STAGE2(PG8_SA(0, 0), cA, vA[0][0], vA[0][1]); PG8_STAGE2(PG8_SA(0, 1), cA, vA[1][0], vA[1][1]);
    if (wr == 1) PG8_BAR;
    PG8_WAIT_V(2); PG8_BAR;
    PG8_STAGEB(PG8_SB(1, 0), cB + kstepB); PG8_STAGE2(PG8_SA(1, 0), cA + kstepA, vA[0][0], vA[0][1]); PG8_STAGEB(PG8_SB(1, 1), cB + hstepB + kstepB);
    PG8_WAIT_V(6); PG8_BAR;
    for (;;) {
        const bool has_next = S.next(ui + 1, nxt);
        const char* nA = has_next ? nxt.A : cA; const char* nB = has_next ? nxt.B : cB;
        if constexpr (Sched::GATHER) {
            if (has_next) {
#pragma unroll
                for (int i = 0; i < 2; ++i) { nA_[0][i] = S.gatherA(nxt, Rs[i], Cs[i]); nA_[1][i] = S.gatherA(nxt, Rs[i] + 128, Cs[i]); }
            } else {
#pragma unroll
                for (int i = 0; i < 2; ++i) { nA_[0][i] = vA[0][i]; nA_[1][i] = vA[1][i]; }
            }
        }
#ifdef PROBE_SEL
        PSTAMP(pa_);
#endif
        for (int t = 0; t < nt; t += 2) {
            const bool last = (t == nt - 2);
            const char* a1 = cA + (size_t)(t + 1) * kstepA;
            const char* a2 = last ? nA : cA + (size_t)(t + 2) * kstepA; const char* b2 = last ? nB : cB + (size_t)(t + 2) * kstepB;
            const char* a3 = a2 + kstepA; const char* b3 = b2 + kstepB;
            unsigned x00 = vA[0][0], x01 = vA[0][1], x10 = vA[1][0], x11 = vA[1][1];
            if constexpr (Sched::GATHER) { if (last) { x00 = nA_[0][0]; x01 = nA_[0][1]; x10 = nA_[1][0]; x11 = nA_[1][1]; } }
            const int nsr = ns_prev; ns_prev = 0; asm volatile("" : "+s"(ns_prev));
            PG8_LDB(B0, 0, 0); PG8_LDB(B1, 0, 1); PG8_SCHED; PG8_LDA(At, 0, 0); PG8_STAGE2(PG8_SA(1, 1), a1, vA[1][0], vA[1][1]);
            PG8_WAIT_VR(nsr); PG8_WAIT_L(0); PG8_BAR; PG8_MMA(0, 0, At, B0); PG8_MMA(0, 1, At, B1); PG8_BAR; PG8_SCHED;
            PG8_LDA(At, 0, 1); PG8_STAGEB(PG8_SB(0, 0), b2); PG8_STAGEB(PG8_SB(0, 1), b2 + hstepB); PG8_STAGE2(PG8_SA(0, 0), a2, x00, x01);
            PG8_WAIT_VR(nsr); PG8_WAIT_L(0); PG8_BAR; PG8_MMA(1, 0, At, B0); PG8_MMA(1, 1, At, B1); PG8_BAR; PG8_SCHED;
            PG8_LDB(B0, 1, 0); PG8_LDB(B1, 1, 1); PG8_SCHED; PG8_LDA(At, 1, 0); PG8_STAGE2(PG8_SA(0, 1), a2, x10, x11);
            PG8_WAIT_V(8); PG8_WAIT_L(0); PG8_BAR; PG8_MMA(0, 0, At, B0); PG8_MMA(0, 1, At, B1); PG8_BAR; PG8_SCHED;
            PG8_LDA(At, 1, 1); PG8_STAGEB(PG8_SB(1, 0), b3); PG8_STAGEB(PG8_SB(1, 1), b3 + hstepB); PG8_STAGE2(PG8_SA(1, 0), a3, x00, x01);
            PG8_WAIT_V(8); PG8_WAIT_L(0); PG8_BAR; PG8_MMA(1, 0, At, B0); PG8_MMA(1, 1, At, B1); PG8_BAR; PG8_SCHED;
        }
#ifdef PROBE_SEL
        PSTAMP(pb_); pk_ += pb_ - pa_;
#endif
        if (wr == 0) PG8_BAR;
        E(acc, cur, wr, wc, fr, fq); ns_prev = E.nstores(cur);
#ifdef PROBE_SEL
        PSTAMP(pa_); pe_ += pa_ - pb_;
#endif
        if (!has_next) break;
        cur = nxt; cA = nA; cB = nB; ++ui;
        if constexpr (Sched::GATHER) {
#pragma unroll
            for (int i = 0; i < 2; ++i) { vA[0][i] = nA_[0][i]; vA[1][i] = nA_[1][i]; }
        }
        if (wr == 1) PG8_BAR;
    }
    PG8_WAIT_V(0);
    PG8_BAR;
#ifdef PROBE_SEL
    if (Sched::PROBE && blockIdx.x == PROBE_BLOCK && tid == 0) { const unsigned long long tot = __builtin_amdgcn_s_memrealtime() - pt0_;
        LAS unsigned long long* pr = (LAS unsigned long long*)(lds + MISC_OFF + 3072);
        pr[0] += (PROBE_SEL == 0 ? pk_ : (PROBE_SEL == 1 ? pe_ : (PROBE_SEL == 2 ? tot - pk_ - pe_ : tot))); }
#endif
#undef PSTAMP
#undef PG8_SA
#undef PG8_SB
#undef PG8_STAGE2
#undef PG8_STAGEB
#undef PG8_LDA
#undef PG8_LDB
#undef PG8_MMA
#undef PG8_WAIT_V
#undef PG8_WAIT_L
#undef PG8_WAIT_VR
#undef PG8_BAR
#undef PG8_SCHED
}
}
using pg8::GU; using pg8::Acc;

struct Args { const float* in[22]; float* out; unsigned char* ws; int ph_lo, ph_hi; };
struct Frame {
    LAS unsigned char* lds;
    int tid, lane, wave, G, vcu;
    unsigned char* ws;
};
enum { IN_X = 0, IN_MEM, IN_WIN, IN_WGATE, IN_BGATE, IN_WMEMKV, IN_RPB, IN_WFO, IN_WNAO, IN_WMEMO, IN_WOUT, IN_LN1G, IN_LN1B,
       IN_WRG, IN_BRG, IN_WRE, IN_BRE, IN_WEG, IN_WEU, IN_WED, IN_LN2G, IN_LN2B };

DI void cvt_row_1024(const float* src, bf16_t* dst, int lane) {
#pragma unroll
    for (int j = 0; j < 2; ++j) {
        const f32x4 a = *(const f32x4*)(src + j * 512 + lane * 8), b = *(const f32x4*)(src + j * 512 + lane * 8 + 4);
        u32x4 o; o.x = pk2(a.x, a.y); o.y = pk2(a.z, a.w); o.z = pk2(b.x, b.y); o.w = pk2(b.z, b.w);
        *(u32x4*)(dst + j * 512 + lane * 8) = o;
    }
}
DI void tr_tile(const float* W, int ldw, int colbase, int k0, bf16_t* WT, int ldt, int drow0, LAS float* scr, int lane) {
    float tv[32];
#pragma unroll
    for (int i = 0; i < 32; ++i) tv[i] = __builtin_nontemporal_load(W + (size_t)(k0 + 2 * i + (lane >> 5)) * ldw + colbase + (lane & 31));
#pragma unroll
    for (int i = 0; i < 32; ++i) scr[(2 * i + (lane >> 5)) * 33 + (lane & 31)] = tv[i];
    LDS_WAIT(); asm volatile("" ::: "memory");
    const int c = lane & 7;
#pragma unroll
    for (int j = 0; j < 4; ++j) { const int n = (lane >> 3) + 8 * j; const LAS float* s = scr + (8 * c) * 33 + n;
        u32x4 o; o.x = pk2(s[0 * 33], s[1 * 33]); o.y = pk2(s[2 * 33], s[3 * 33]); o.z = pk2(s[4 * 33], s[5 * 33]); o.w = pk2(s[6 * 33], s[7 * 33]);
        *(u32x4*)(WT + (size_t)(drow0 + n) * ldt + k0 + 8 * c) = o; }
    LDS_WAIT(); asm volatile("" ::: "memory");
}
DI void tr_item(const float* W, int ldw, int col0, int ncols, bf16_t* WT, int K, int row_off, LAS float* scr, int item, int lane) {
    const int nblk = ncols / 32, kb = item / nblk, nb = item % nblk;
    tr_tile(W, ldw, col0 + 32 * nb, 64 * kb, WT, K, row_off + 32 * nb, scr, lane);
}
DI void fold_item(const float* w_in, bf16_t* W1t, LAS float* scr, int item, int lane) {
    const int g = item >> 9, k0 = ((item >> 1) & 255) * 4, cp = (item & 1) * 64 + lane;
    LAS float* wt = scr;
    LAS float* tc = scr + 512;
    LAS float* ts = scr + 640;
#pragma unroll
    for (int j = 0; j < 2; ++j) { const int idx = lane + 64 * j, kk = idx >> 5, c4 = idx & 31;
        const f32x4 v = *(const f32x4*)(w_in + (size_t)(k0 + kk) * 2560 + g * 128 + 4 * c4);
        *(LAS f32x4*)(wt + kk * 128 + 4 * c4) = v; }
#pragma unroll
    for (int j = 0; j < 2; ++j) { const int i = lane + 64 * j; float sv, cv; sincospif((float)i * (1.0f / 64.0f), &sv, &cv); tc[i] = cv; ts[i] = sv; }
    LDS_WAIT(); asm volatile("" ::: "memory");
    float re[4], im[4];
#pragma unroll
    for (int kk = 0; kk < 4; ++kk) { re[kk] = 0.f; im[kk] = 0.f; }
    for (int c = 0; c < 128; ++c) {
        const int idx = (c * cp) & 127; const float cs = tc[idx], sn = ts[idx];
#pragma unroll
        for (int kk = 0; kk < 4; ++kk) { const float w = wt[kk * 128 + c]; re[kk] += w * cs; im[kk] -= w * sn; }
    }
    const float sc = 0.08838834764831845f;
    u32x2 o;
    o.x = pk2(re[0] * sc, re[1] * sc); o.y = pk2(re[2] * sc, re[3] * sc);
    *(u32x2*)(W1t + (size_t)(g * 256 + cp) * 1024 + k0) = o;
    o.x = pk2(im[0] * sc, im[1] * sc); o.y = pk2(im[2] * sc, im[3] * sc);
    *(u32x2*)(W1t + (size_t)(g * 256 + 128 + cp) * 1024 + k0) = o;
    LDS_WAIT(); asm volatile("" ::: "memory");
}
DI void p0_prologue(const Frame& F, const Args& a) {
    LAS float* scr = (LAS float*)(F.lds + F.wave * 16384);
    const int gw = F.vcu * 8 + F.wave, NGW = F.G * 8, lane = F.lane;
    unsigned char* ws = F.ws;
    bf16_t* W1t = (bf16_t*)(ws + WS_W1T);
    constexpr int I_IN = 16 * 64, I_GATE = 16 * 96, I_KV = 16 * 32, I_BR = 8 * 32, I_OUT = 16 * 32, I_FOLD = 2048;
    constexpr int NITEMS = I_FOLD + I_IN + I_GATE + I_KV + 3 * I_BR + I_OUT;
    for (int it = gw; it < NITEMS; it += NGW) {
        int r = it;
        if (r < I_FOLD) { fold_item(a.in[IN_WIN], W1t, scr, r, lane); continue; } r -= I_FOLD;
        if (r < I_IN) { tr_item(a.in[IN_WIN], 2560, 512, 2048, W1t, 1024, 1024, scr, r, lane); continue; } r -= I_IN;
        if (r < I_GATE) { tr_item(a.in[IN_WGATE], 3072, 0, 3072, W1t, 1024, 3072, scr, r, lane); continue; } r -= I_GATE;
        if (r < I_KV) { tr_item(a.in[IN_WMEMKV], 1024, 0, 1024, (bf16_t*)(ws + WS_WKVT), 1024, 0, scr, r, lane); continue; } r -= I_KV;
        if (r < I_BR) { tr_item(a.in[IN_WFO], 1024, 0, 1024, (bf16_t*)(ws + WS_WFOT), 512, 0, scr, r, lane); continue; } r -= I_BR;
        if (r < I_BR) { tr_item(a.in[IN_WNAO], 1024, 0, 1024, (bf16_t*)(ws + WS_WNAT), 512, 0, scr, r, lane); continue; } r -= I_BR;
        if (r < I_BR) { tr_item(a.in[IN_WMEMO], 1024, 0, 1024, (bf16_t*)(ws + WS_WMOT), 512, 0, scr, r, lane); continue; } r -= I_BR;
        tr_item(a.in[IN_WOUT], 1024, 0, 1024, (bf16_t*)(ws + WS_WOUTT), 1024, 0, scr, r, lane);
    }
    for (int m = gw; m < T; m += 2 * NGW) {
        const float* s0 = a.in[IN_X] + (size_t)m * DM; const int m1 = m + NGW < T ? m + NGW : m; const float* s1 = a.in[IN_X] + (size_t)m1 * DM;
        f32x4 va[4], vb[4];
#pragma unroll
        for (int j = 0; j < 2; ++j) { va[2 * j] = __builtin_nontemporal_load((const f32x4*)(s0 + j * 512 + lane * 8)); va[2 * j + 1] = __builtin_nontemporal_load((const f32x4*)(s0 + j * 512 + lane * 8 + 4));
                                      vb[2 * j] = __builtin_nontemporal_load((const f32x4*)(s1 + j * 512 + lane * 8)); vb[2 * j + 1] = __builtin_nontemporal_load((const f32x4*)(s1 + j * 512 + lane * 8 + 4)); }
        bf16_t* d0 = (bf16_t*)(ws + WS_XB) + (size_t)m * DM; bf16_t* d1 = (bf16_t*)(ws + WS_XB) + (size_t)m1 * DM;
#pragma unroll
        for (int j = 0; j < 2; ++j) { u32x4 o; o.x = pk2(va[2 * j].x, va[2 * j].y); o.y = pk2(va[2 * j].z, va[2 * j].w); o.z = pk2(va[2 * j + 1].x, va[2 * j + 1].y); o.w = pk2(va[2 * j + 1].z, va[2 * j + 1].w);
            *(u32x4*)(d0 + j * 512 + lane * 8) = o;
            o.x = pk2(vb[2 * j].x, vb[2 * j].y); o.y = pk2(vb[2 * j].z, vb[2 * j].w); o.z = pk2(vb[2 * j + 1].x, vb[2 * j + 1].y); o.w = pk2(vb[2 * j + 1].z, vb[2 * j + 1].w);
            *(u32x4*)(d1 + j * 512 + lane * 8) = o; }
    }
    for (int m = gw; m < NBATCH * MEML; m += NGW) cvt_row_1024(a.in[IN_MEM] + (size_t)m * DM, (bf16_t*)(ws + WS_MEMB) + (size_t)m * DM, lane);
    const int gt = F.vcu * 512 + F.tid, NGT = F.G * 512;
    { bf16_t* wr = (bf16_t*)(ws + WS_WRT);
      for (int i = gt; i < 80 * 1024; i += NGT) { const int r = i >> 10, k = i & 1023;
          const float v = r < 64 ? a.in[IN_WRE][k * 64 + r] : (r < 72 ? a.in[IN_WRG][k * 8 + (r - 64)] : 0.f);
          wr[i] = (bf16_t)(pk2(v, 0.f) & 0xffffu); } }
    { bf16_t* f = (bf16_t*)(ws + WS_F64);
      for (int i = gt; i < 128 * 128; i += NGT) { const int j = i & 7, ln = (i >> 3) & 63, nt = (i >> 9) & 7, ks = i >> 12;
          const int k = 32 * ks + 8 * (ln >> 4) + j, m = 16 * nt + (ln & 15), ri = k >> 6, n1 = k & 63, rip = m >> 6, k1 = m & 63;
          float sv, cv; sincospif((float)((n1 * k1) & 63) * (1.0f / 32.0f), &sv, &cv);
          const float v = (ri == rip) ? cv : (ri == 1 ? sv : -sv);
          f[i] = (bf16_t)(pk2(v * 0.125f, 0.f) & 0xffffu); } }
    { bf16_t* f = (bf16_t*)(ws + WS_C128);
      for (int i = gt; i < 256 * 128; i += NGT) { const int j = i & 7, ln = (i >> 3) & 63, nt = (i >> 9) & 7, ks = i >> 12;
          const int k = 32 * ks + 8 * (ln >> 4) + j, k2 = 16 * nt + (ln & 15), rip = k >> 7, n2 = k & 127;
          float sv, cv; sincospif((float)((n2 * k2) & 127) * (1.0f / 64.0f), &sv, &cv);
          f[i] = (bf16_t)(pk2((rip == 0 ? cv : sv) * 0.08838834764831845f, 0.f) & 0xffffu); } }
}
struct TrDesc { const float* src; bf16_t* dst; int ldw, ldt; int nt; };
DI void tr_load(float (&tv)[32], const TrDesc& d, int lane) {
#pragma unroll
    for (int i = 0; i < 32; ++i) tv[i] = __builtin_nontemporal_load(d.src + (size_t)(2 * i + (lane >> 5)) * d.ldw + (lane & 31));
}
DI void tr_store(const float (&tv)[32], const TrDesc& d, LAS float* scr, int lane) {
#pragma unroll
    for (int i = 0; i < 32; ++i) scr[(2 * i + (lane >> 5)) * 33 + (lane & 31)] = tv[i];
    LDS_WAIT(); asm volatile("" ::: "memory");
    const int c = lane & 7;
#pragma unroll
    for (int j = 0; j < 4; ++j) { const int n = (lane >> 3) + 8 * j; const LAS float* p = scr + (8 * c) * 33 + n;
        u32x4 o; o.x = pk2(p[0 * 33], p[1 * 33]); o.y = pk2(p[2 * 33], p[3 * 33]); o.z = pk2(p[4 * 33], p[5 * 33]); o.w = pk2(p[6 * 33], p[7 * 33]);
        if (d.nt) __builtin_nontemporal_store(o, (u32x4*)(d.dst + (size_t)n * d.ldt + 8 * c)); else *(u32x4*)(d.dst + (size_t)n * d.ldt + 8 * c) = o; }
    LDS_WAIT(); asm volatile("" ::: "memory");
}
template <class Dec> DI void tr_run(const Dec& dec, int first, int n, int stride, LAS float* scr, int lane) {
    if (first >= n) return;
    TrDesc d0 = dec(first); float ta[32], tb[32];
    tr_load(ta, d0, lane);
    for (int it = first; it < n; it += 2 * stride) {
        const TrDesc d1 = dec(min(it + stride, n - 1)); tr_load(tb, d1, lane);
        tr_store(ta, d0, scr, lane);
        if (it + stride >= n) break;
        d0 = dec(min(it + 2 * stride, n - 1)); tr_load(ta, d0, lane);
        tr_store(tb, d1, scr, lane);
    }
}
struct DecGU { const float* weg; const float* weu; bf16_t* wgu;
    DI TrDesc operator()(int it) const { const int e = it >> 9; int r = it & 511; const int up = r >> 8; r &= 255; const int kb = r >> 4, nb = r & 15, n0 = 32 * nb;
        const float* wsel = (const float*)((size_t)weg + (size_t)up * ((size_t)weu - (size_t)weg));
        TrDesc d; d.src = wsel + (size_t)e * 1024 * 512 + (size_t)(64 * kb) * 512 + n0; d.ldw = 512;
        d.dst = wgu + (size_t)e * 1024 * 1024 + (size_t)((n0 >> 7) * 256 + up * 128 + (n0 & 127)) * 1024 + 64 * kb; d.ldt = 1024; d.nt = 1; return d; } };
struct DecDown { const float* wed; bf16_t* wd;
    DI TrDesc operator()(int it) const { const int e = it >> 8, r = it & 255, kb = r >> 5, nb = r & 31;
        TrDesc d; d.src = wed + (size_t)e * 512 * 1024 + (size_t)(64 * kb) * 1024 + 32 * nb; d.ldw = 1024;
        d.dst = wd + (size_t)e * 1024 * 512 + (size_t)(32 * nb) * 512 + 64 * kb; d.ldt = 512; d.nt = 0; return d; } };
DI void p_expert_cvt_gu(const Frame& F, const Args& a) {
    DecGU dec{a.in[IN_WEG], a.in[IN_WEU], (bf16_t*)(F.ws + WS_WGUT)};
    int lane = F.lane; asm volatile("" : "+v"(lane));
    tr_run(dec, F.vcu * 8 + F.wave, NEXP * 512, F.G * 8, (LAS float*)(F.lds + F.wave * 16384), lane);
}
DI void p_expert_cvt_down(const Frame& F, const Args& a, int part, int nparts) {
    DecDown dec{a.in[IN_WED], (bf16_t*)(F.ws + WS_WDT)};
    int lane = F.lane; asm volatile("" : "+v"(lane));
    tr_run(dec, part * 8 + F.wave, NEXP * 256, nparts * 8, (LAS float*)(F.lds + F.wave * 16384), lane);
}

template <bool BIAS> struct EpiP1 {
    static constexpr bool PERM = true;
    DI int nstores(const GU&) const { return 16; }
    unsigned char* ws; const float* bgate;
    DI void operator()(Acc& acc, const GU& u, int wr, int wc, int fr, int fq) const {
        bf16_t* base; int ncols; float sc = 1.f;
        if constexpr (BIAS) { base = (bf16_t*)(ws + WS_GATES); ncols = 3072; }
        else switch (u.p0) {
            case 0: base = (bf16_t*)(ws + WS_ZT); ncols = 8192; break;
            case 1: base = (bf16_t*)(ws + WS_Q); ncols = 512; sc = 0.125f * 1.4426950408889634f; break;
            case 2: base = (bf16_t*)(ws + WS_K); ncols = 512; break;
            case 3: base = (bf16_t*)(ws + WS_VT); ncols = 8192; break;
            case 4: base = (bf16_t*)(ws + WS_QM); ncols = 512; sc = 0.08838834764831845f * 1.4426950408889634f; break;
            case 6: base = (bf16_t*)(ws + WS_KVM); ncols = 512; break;
            default: base = (bf16_t*)(ws + WS_KVM + MiB); ncols = 256; break;
        }
        const int row0 = u.p1 * 256 + wr * 64 + fr, col0 = u.p2 * 256 + wc * 32 + 8 * fq;
        f32x4 bv[2][2];
        if constexpr (BIAS) {
            const float* bias = bgate + col0;
#pragma unroll
            for (int bj = 0; bj < 2; ++bj)
#pragma unroll
                for (int n = 0; n < 2; ++n) bv[bj][n] = *(const f32x4*)(bias + bj * 128 + 4 * n) * (-1.4426950408889634f);
        }
#pragma unroll
        for (int ai = 0; ai < 2; ++ai)
#pragma unroll
            for (int m = 0; m < 4; ++m) {
#pragma unroll
                for (int bj = 0; bj < 2; ++bj) { f32x4 v0 = acc[ai][bj][m][0], v1 = acc[ai][bj][m][1];
                    if constexpr (BIAS) {
                        v0 = v0 * (-1.4426950408889634f) + bv[bj][0]; v1 = v1 * (-1.4426950408889634f) + bv[bj][1];
#pragma unroll
                        for (int j = 0; j < 4; ++j) { v0[j] = __builtin_amdgcn_exp2f(v0[j]); v1[j] = __builtin_amdgcn_exp2f(v1[j]); }
                        v0 = v0 + 1.0f; v1 = v1 + 1.0f;
#pragma unroll
                        for (int j = 0; j < 4; ++j) { v0[j] = fmaxf(__builtin_amdgcn_rcpf(v0[j]), 9.5367431640625e-07f); v1[j] = fmaxf(__builtin_amdgcn_rcpf(v1[j]), 9.5367431640625e-07f); }
                    } else { v0 = v0 * sc; v1 = v1 * sc; }
                    u32x4 w; w.x = pk2(v0[0], v0[1]); w.y = pk2(v0[2], v0[3]); w.z = pk2(v1[0], v1[1]); w.w = pk2(v1[2], v1[3]);
                    if constexpr (BIAS) __builtin_nontemporal_store(w, (u32x4*)(base + blk_off(row0 + ai * 128 + m * 16, col0 + bj * 128, ncols)));
                    else *(u32x4*)(base + blk_off(row0 + ai * 128 + m * 16, col0 + bj * 128, ncols)) = w;
                    acc[ai][bj][m][0] = (f32x4){0.f, 0.f, 0.f, 0.f}; acc[ai][bj][m][1] = (f32x4){0.f, 0.f, 0.f, 0.f}; } }
    }
};
struct SchedP1F {
    static constexpr bool GATHER = false; static constexpr bool PROBE = false;
    int K, G, c; const char* xb; const char* w1t;
    DI unsigned voffA(int r, int c) const { return pg8::off_plain(r, c, 1024); }
    DI unsigned hstepA() const { return 128u * 2048u; }
    DI unsigned kstepA() const { return 128u; }
    DI unsigned voffB(int r, int c) const { return pg8::off_plain((r & 63) * 128 + (r >> 6), c, 1024); }
    DI unsigned hstepB() const { return 2u * 2048u; }
    DI unsigned kstepB() const { return 128u; }
    DI unsigned gatherA(const GU&, int, int) const { return 0u; }
    DI bool next(int i, GU& u) const {
        const int L = i * G + c; if (L >= 512) return false;
        int pm, pn; pg8::tile_order(L, 128, 4, pm, pn);
        const int b = pm >> 5, pp = pm & 31;
        u.A = w1t + (size_t)pn * 256 * 2048; u.B = xb + ((size_t)b * 8192 + 4 * pp) * 2048;
        u.p0 = 0; u.p1 = b * 4 + pn; u.p2 = pp; u.p3 = 0; return true;
    }
};
struct SchedP1a {
    static constexpr bool GATHER = false; static constexpr bool PROBE = false;
    int K, G, c; const char* xb; const char* w1t; const char* memb; const char* wkvt;
    DI unsigned voffA(int r, int c) const { return pg8::off_plain(r, c, 1024); }
    DI unsigned hstepA() const { return 128u * 2048u; }
    DI unsigned kstepA() const { return 128u; }
    DI unsigned voffB(int r, int c) const { return pg8::off_plain(r, c, 1024); }
    DI unsigned hstepB() const { return 128u * 2048u; }
    DI unsigned kstepB() const { return 128u; }
    DI unsigned gatherA(const GU&, int, int) const { return 0u; }
    DI bool next(int i, GU& u) const {
        const int L = i * G + c; u.p3 = 0;
        if (L < 1024) {
            int pm, pn; pg8::tile_order(L, 128, 8, pm, pn);
            const char* xt = xb + (size_t)pm * 256 * 2048;
            if (pn < 2)       { u.A = xt; u.B = w1t + (size_t)(1024 + 256 * pn) * 2048; u.p0 = 1; u.p1 = pm; u.p2 = pn; }
            else if (pn < 4)  { u.A = xt; u.B = w1t + (size_t)(1536 + 256 * (pn - 2)) * 2048; u.p0 = 2; u.p1 = pm; u.p2 = pn - 2; }
            else if (pn < 6)  { u.A = w1t + (size_t)(2048 + 256 * (pn - 4)) * 2048; u.B = xt; u.p0 = 3; u.p1 = (pm >> 5) * 2 + (pn - 4); u.p2 = pm & 31; }
            else              { u.A = xt; u.B = w1t + (size_t)(2560 + 256 * (pn - 6)) * 2048; u.p0 = 4; u.p1 = pm; u.p2 = pn - 6; }
            return true;
        }
        return false;
    }
};
struct SchedKV {
    static constexpr bool GATHER = false; static constexpr bool PROBE = false;
    int K, j; const char* memb; const char* wkvt;
    DI unsigned voffA(int r, int c) const { return pg8::off_plain(r, c, 1024); }
    DI unsigned hstepA() const { return 128u * 2048u; }
    DI unsigned kstepA() const { return 128u; }
    DI unsigned voffB(int r, int c) const { return pg8::off_plain(r, c, 1024); }
    DI unsigned hstepB() const { return 128u * 2048u; }
    DI unsigned kstepB() const { return 128u; }
    DI unsigned gatherA(const GU&, int, int) const { return 0u; }
    DI bool next(int i, GU& u) const {
        if (i > 0 || j < 0) return false; u.p3 = 0;
        if (j < 8) { const int pm = j >> 1, pn = j & 1; u.A = memb + (size_t)pm * 256 * 2048; u.B = wkvt + (size_t)pn * 256 * 2048; u.p0 = 6; u.p1 = pm; u.p2 = pn; }
        else { const int f = (j - 8) >> 2, b = (j - 8) & 3; u.A = wkvt + (size_t)(512 + 256 * f) * 2048; u.B = memb + (size_t)b * 256 * 2048; u.p0 = 7; u.p1 = b * 2 + f; u.p2 = 0; }
        return true;
    }
};
struct SchedP1g {
    static constexpr bool GATHER = false; static constexpr bool PROBE = false;
    int K, G, c; const char* xb; const char* w1t;
    DI unsigned voffA(int r, int c) const { return pg8::off_plain(r, c, 1024); }
    DI unsigned hstepA() const { return 128u * 2048u; }
    DI unsigned kstepA() const { return 128u; }
    DI unsigned voffB(int r, int c) const { return pg8::off_plain(r, c, 1024); }
    DI unsigned hstepB() const { return 128u * 2048u; }
    DI unsigned kstepB() const { return 128u; }
    DI unsigned gatherA(const GU&, int, int) const { return 0u; }
    DI bool next(int i, GU& u) const {
        const int L = i * G + c; if (L >= 1536) return false;
        int pm, pn; pg8::tile_order(L, 128, 12, pm, pn);
        u.A = xb + (size_t)pm * 256 * 2048; u.B = w1t + (size_t)(3072 + 256 * pn) * 2048; u.p0 = 5; u.p1 = pm; u.p2 = pn; u.p3 = 0; return true;
    }
};

struct EpiMerge {
    static constexpr bool PERM = true;
    DI int nstores(const GU& u) const { return u.p0 == 2 ? 16 : 0; }
    const bf16_t* gates; bf16_t* merged;
    DI void operator()(Acc& acc, const GU& u, int wr, int wc, int fr, int fq) const {
        const int seg = u.p0, pm = u.p1, pn = u.p2;
        const int row0 = pm * 256 + wr * 64 + fr, col0 = pn * 256 + wc * 32 + 8 * fq;
        const int nxt_off = seg < 2 ? 1024 : 0;
#pragma unroll
        for (int ai = 0; ai < 2; ++ai) {
            u32x4 ga[8], gb[8];
#pragma unroll
            for (int m = 0; m < 4; ++m)
#pragma unroll
                for (int bj = 0; bj < 2; ++bj) { const int gr = row0 + ai * 128 + m * 16, gc = seg * 1024 + col0 + bj * 128;
                    ga[m * 2 + bj] = __builtin_nontemporal_load((const u32x4*)(gates + blk_off(gr, gc, 3072)));     gb[m * 2 + bj] = *(const u32x4*)(gates + blk_off(gr, gc + nxt_off, 3072)); }
            asm volatile("" ::: "memory");
#pragma unroll
            for (int m = 0; m < 4; ++m) { const size_t r = (size_t)(row0 + ai * 128 + m * 16);
#pragma unroll
                for (int bj = 0; bj < 2; ++bj) {
                    const u32x4 xa = ga[m * 2 + bj], xb = gb[m * 2 + bj];
                    float g[8] = {bf_lo(xa.x), bf_hi(xa.x), bf_lo(xa.y), bf_hi(xa.y), bf_lo(xa.z), bf_hi(xa.z), bf_lo(xa.w), bf_hi(xa.w)};
                    const float h[8] = {bf_lo(xb.x), bf_hi(xb.x), bf_lo(xb.y), bf_hi(xb.y), bf_lo(xb.z), bf_hi(xb.z), bf_lo(xb.w), bf_hi(xb.w)};
                    if (seg < 2) {
#pragma unroll
                        for (int j = 0; j < 8; ++j) g[j] = g[j] * __builtin_amdgcn_rcpf(h[j]);
                    }
                    f32x4 v0 = acc[ai][bj][m][0], v1 = acc[ai][bj][m][1];
#pragma unroll
                    for (int j = 0; j < 4; ++j) { v0[j] *= g[j]; v1[j] *= g[4 + j]; }
                    if (seg == 2) {
                        u32x4 w; w.x = pk2(v0[0], v0[1]); w.y = pk2(v0[2], v0[3]); w.z = pk2(v1[0], v1[1]); w.w = pk2(v1[2], v1[3]);
                        *(u32x4*)(merged + r * 1024 + col0 + bj * 128) = w;
                        v0 = (f32x4){0.f, 0.f, 0.f, 0.f}; v1 = v0;
                    }
                    acc[ai][bj][m][0] = v0; acc[ai][bj][m][1] = v1; } }
        }
    }
};
struct SchedMerge {
    static constexpr bool GATHER = false; static constexpr bool PROBE = false;
    int K, G, c; const char* a0; const char* b0;
    DI unsigned voffA(int r, int c) const { return pg8::off_plain(r, c, 512); }
    DI unsigned hstepA() const { return 128u * 1024u; }
    DI unsigned kstepA() const { return 128u; }
    DI unsigned voffB(int r, int c) const { return pg8::off_plain(r, c, 512); }
    DI unsigned hstepB() const { return 128u * 1024u; }
    DI unsigned kstepB() const { return 128u; }
    DI unsigned gatherA(const GU&, int, int) const { return 0u; }
    DI bool next(int i, GU& u) const {
        const int tile = i / 3, seg = i - 3 * tile, L = tile * G + c; if (L >= 512) return false;
        int pm, pn; pg8::tile_order(L, 128, 4, pm, pn);
        u.A = a0 + (size_t)seg * (32 * MiB) + (size_t)pm * 256 * 1024; u.B = b0 + (size_t)seg * MiB + (size_t)pn * 256 * 1024; u.p0 = seg; u.p1 = pm; u.p2 = pn; u.p3 = 0; return true;
    }
};
static_assert(WS_ONA == WS_Y + 32 * MiB && WS_OMEM == WS_Y + 64 * MiB && WS_WNAT == WS_WFOT + MiB && WS_WMOT == WS_WFOT + 2 * MiB, "P4 segment strides");

struct EpiOut {
    static constexpr bool PERM = true;
    DI int nstores(const GU&) const { return 16; }
    const float* x; bf16_t* v;
    DI void operator()(Acc& acc, const GU& u, int wr, int wc, int fr, int fq) const {
        const int row0 = u.p1 * 256 + wr * 64 + fr, col0 = u.p2 * 256 + wc * 32 + 8 * fq;
#pragma unroll
        for (int ai = 0; ai < 2; ++ai) {
            f32x4 xv[16];
#pragma unroll
            for (int m = 0; m < 4; ++m) { const size_t off = (size_t)(row0 + ai * 128 + m * 16) * 1024 + col0;
#pragma unroll
                for (int bj = 0; bj < 2; ++bj)
#pragma unroll
                    for (int n = 0; n < 2; ++n) xv[m * 4 + bj * 2 + n] = __builtin_nontemporal_load((const f32x4*)(x + off + bj * 128 + n * 4)); }
            asm volatile("" ::: "memory");
#pragma unroll
            for (int m = 0; m < 4; ++m) { const size_t off = (size_t)(row0 + ai * 128 + m * 16) * 1024 + col0;
#pragma unroll
                for (int bj = 0; bj < 2; ++bj) { const f32x4 v0 = xv[m * 4 + bj * 2] * ALPHA + acc[ai][bj][m][0], v1 = xv[m * 4 + bj * 2 + 1] * ALPHA + acc[ai][bj][m][1];
                    u32x4 w; w.x = pk2(v0[0], v0[1]); w.y = pk2(v0[2], v0[3]); w.z = pk2(v1[0], v1[1]); w.w = pk2(v1[2], v1[3]);
                    *(u32x4*)(v + blk_off(row0 + ai * 128 + m * 16, col0 + bj * 128, 1024)) = w;
                    acc[ai][bj][m][0] = (f32x4){0.f, 0.f, 0.f, 0.f}; acc[ai][bj][m][1] = (f32x4){0.f, 0.f, 0.f, 0.f}; } }
        }
    }
};
struct SchedOut {
    static constexpr bool GATHER = false; static constexpr bool PROBE = false;
    int K, G, c; const char* a; const char* b;
    DI unsigned voffA(int r, int c) const { return pg8::off_plain(r, c, 1024); }
    DI unsigned hstepA() const { return 128u * 2048u; }
    DI unsigned kstepA() const { return 128u; }
    DI unsigned voffB(int r, int c) const { return pg8::off_plain(r, c, 1024); }
    DI unsigned hstepB() const { return 128u * 2048u; }
    DI unsigned kstepB() const { return 128u; }
    DI unsigned gatherA(const GU&, int, int) const { return 0u; }
    DI bool next(int i, GU& u) const {
        const int L = i * G + c; if (L >= 512) return false;
        int pm, pn; pg8::tile_order(L, 128, 4, pm, pn);
        u.A = a + (size_t)pm * 256 * 2048; u.B = b + (size_t)pn * 256 * 2048; u.p0 = 0; u.p1 = pm; u.p2 = pn; u.p3 = 0; return true;
    }
};

DI void moe_tables(const Frame& F) {
    LAS int* tstart = (LAS int*)(F.lds + MISC_OFF + MS_TSTART); LAS int* cnt = (LAS int*)(F.lds + MISC_OFF + MS_CNT);
    LAS unsigned short* tile_e = (LAS unsigned short*)(F.lds + MISC_OFF + MS_TILEE);
    const unsigned* gcnt = (const unsigned*)(F.ws + WS_CTL) + CW_GCNT;
    __syncthreads();
    if (F.tid < 64) { int c = (int)__hip_atomic_load(gcnt + F.tid, __ATOMIC_RELAXED, __HIP_MEMORY_SCOPE_AGENT); c = c > LIST_CAP ? LIST_CAP : c; cnt[F.tid] = c; }
    __syncthreads();
    if (F.tid == 0) { int s = 0; for (int e = 0; e < 64; ++e) { tstart[e] = s; s += (cnt[e] + 255) >> 8; } tstart[64] = s; }
    __syncthreads();
    if (F.tid < 64) { const int e = F.tid; for (int t = tstart[e]; t < tstart[e + 1]; ++t) tile_e[t] = (unsigned short)e; }
    __syncthreads();
}
DI bool moe_unit(int i, int G, int c, int ntiles, int& tau, int& pn) {
    if (G % 8 != 0) { const int L = i * G + c; tau = L >> 2; pn = L & 3; return tau < ntiles; }
    const int x = c & 7, r = c >> 3, per = G >> 3, base = ntiles >> 3, rem = ntiles & 7;
    const int t0 = x * base + (x < rem ? x : rem), cnt = base + (x < rem ? 1 : 0);
    const int u = i * per + r; if (u >= 4 * cnt) return false;
    tau = t0 + (u >> 2); pn = u & 3; return true;
}
struct SchedMoeGU {
    static constexpr bool GATHER = true; static constexpr bool PROBE = false;
    int K, G, c; const char* h; const char* wgu; const int* list; LAS unsigned char* misc;
    DI unsigned voffA(int, int) const { return 0u; }
    DI unsigned hstepA() const { return 0u; }
    DI unsigned kstepA() const { return 128u; }
    DI unsigned voffB(int r, int c) const { return pg8::off_plain(r, c, 1024); }
    DI unsigned hstepB() const { return 128u * 2048u; }
    DI unsigned kstepB() const { return 128u; }
    DI unsigned gatherA(const GU& u, int r, int c) const {
        const LAS int* cnt = (const LAS int*)(misc + MS_CNT);
        const int slot = min(u.p1 * 256 + r, cnt[u.p0] - 1);
        return pg8::off_plain(list[(size_t)u.p0 * LIST_CAP + slot], c, 1024);
    }
    DI bool next(int i, GU& u) const {
        const LAS int* tstart = (const LAS int*)(misc + MS_TSTART); const LAS unsigned short* tile_e = (const LAS unsigned short*)(misc + MS_TILEE);
        int tau, pn; if (!moe_unit(i, G, c, tstart[64], tau, pn)) return false;
        const int e = tile_e[tau];
        u.A = h; u.B = wgu + ((size_t)e * 1024 + 256 * pn) * 2048; u.p0 = e; u.p1 = tau - tstart[e]; u.p2 = pn; u.p3 = tau; return true;
    }
};
struct EpiSwiGLU {
    static constexpr bool PERM = true;
    DI int nstores(const GU&) const { return 8; }
    bf16_t* H;
    DI void operator()(Acc& acc, const GU& u, int wr, int wc, int fr, int fq) const {
        const int row0 = u.p3 * 256 + wr * 64 + fr, col0 = u.p2 * 128 + wc * 32 + 8 * fq;
#pragma unroll
        for (int ai = 0; ai < 2; ++ai)
#pragma unroll
            for (int m = 0; m < 4; ++m) {
                float o[8];
#pragma unroll
                for (int n = 0; n < 2; ++n)
#pragma unroll
                    for (int j = 0; j < 4; ++j) { const float g = acc[ai][0][m][n][j], up = acc[ai][1][m][n][j]; o[4 * n + j] = g * fast_sigmoid(g) * up; }
                u32x4 w; w.x = pk2(o[0], o[1]); w.y = pk2(o[2], o[3]); w.z = pk2(o[4], o[5]); w.w = pk2(o[6], o[7]);
                *(u32x4*)(H + (size_t)(row0 + ai * 128 + m * 16) * 512 + col0) = w;
#pragma unroll
                for (int bj = 0; bj < 2; ++bj)
#pragma unroll
                    for (int n = 0; n < 2; ++n) acc[ai][bj][m][n] = (f32x4){0.f, 0.f, 0.f, 0.f}; }
    }
};
struct SchedMoeD {
    static constexpr bool GATHER = false; static constexpr bool PROBE = false;
    int K, G, c; const char* H; const char* wd; LAS unsigned char* misc;
    DI unsigned voffA(int r, int c) const { return pg8::off_plain(r, c, 512); }
    DI unsigned hstepA() const { return 128u * 1024u; }
    DI unsigned kstepA() const { return 128u; }
    DI unsigned voffB(int r, int c) const { return pg8::off_plain(r, c, 512); }
    DI unsigned hstepB() const { return 128u * 1024u; }
    DI unsigned kstepB() const { return 128u; }
    DI unsigned gatherA(const GU&, int, int) const { return 0u; }
    DI bool next(int i, GU& u) const {
        const LAS int* tstart = (const LAS int*)(misc + MS_TSTART); const LAS unsigned short* tile_e = (const LAS unsigned short*)(misc + MS_TILEE);
        int tau, pn; if (!moe_unit(i, G, c, tstart[64], tau, pn)) return false;
        const int e = tile_e[tau];
        u.A = H + (size_t)tau * 256 * 1024; u.B = wd + ((size_t)e * 1024 + 256 * pn) * 1024; u.p0 = e; u.p1 = 0; u.p2 = pn; u.p3 = tau; return true;
    }
};
struct EpiDown {
    static constexpr bool PERM = true;
    DI int nstores(const GU&) const { return 16; }
    bf16_t* Y;
    DI void operator()(Acc& acc, const GU& u, int wr, int wc, int fr, int fq) const {
        const int row0 = u.p3 * 256 + wr * 64 + fr, col0 = u.p2 * 256 + wc * 32 + 8 * fq;
#pragma unroll
        for (int ai = 0; ai < 2; ++ai)
#pragma unroll
            for (int m = 0; m < 4; ++m) {
#pragma unroll
                for (int bj = 0; bj < 2; ++bj) { const f32x4 v0 = acc[ai][bj][m][0], v1 = acc[ai][bj][m][1];
                    u32x4 w; w.x = pk2(v0[0], v0[1]); w.y = pk2(v0[2], v0[3]); w.z = pk2(v1[0], v1[1]); w.w = pk2(v1[2], v1[3]);
                    __builtin_nontemporal_store(w, (u32x4*)(Y + blk_off(row0 + ai * 128 + m * 16, col0 + bj * 128, 1024)));
                    acc[ai][bj][m][0] = (f32x4){0.f, 0.f, 0.f, 0.f}; acc[ai][bj][m][1] = (f32x4){0.f, 0.f, 0.f, 0.f}; } }
    }
};

#define MFMA16(a, b, c) __builtin_amdgcn_mfma_f32_16x16x32_bf16((a), (b), (c), 0, 0, 0)
DI void fft1_item(const bf16_t* zt, bf16_t* t1, const LAS unsigned char* fb, int item, int lane) {
    const int n2h = item & 1, c = (item >> 1) & 127, g = (item >> 8) & 3, b = item >> 10;
    const int fr = lane & 15, fq = lane >> 4, n2_0 = 64 * n2h;
#pragma unroll 1
    for (int a2 = 0; a2 < 2; ++a2) {
        f32x4 acc[2][8];
#pragma unroll
        for (int mt = 0; mt < 2; ++mt)
#pragma unroll
            for (int nt = 0; nt < 8; ++nt) acc[mt][nt] = (f32x4){0.f, 0.f, 0.f, 0.f};
        bf16x8 a[4][2];
#pragma unroll
        for (int ks = 0; ks < 4; ++ks) { const int ri = ks >> 1, n1_0 = 32 * (ks & 1) + 8 * fq;
            const int zrow = b * 1024 + g * 256 + ri * 128 + c;
#pragma unroll
            for (int mt = 0; mt < 2; ++mt) { const int n2 = n2_0 + 32 * a2 + 8 * (fr >> 2) + 4 * mt + (fr & 3);
                a[ks][mt] = __builtin_nontemporal_load((const bf16x8*)(zt + blk_off(zrow, n2 * 64 + n1_0, 8192))); } }
#pragma unroll
        for (int ks = 0; ks < 4; ++ks)
#pragma unroll
            for (int nt = 0; nt < 8; ++nt) { const bf16x8 bf = *(const LAS bf16x8*)(fb + ((ks * 8 + nt) * 64 + lane) * 16);
#pragma unroll
                for (int mt = 0; mt < 2; ++mt) acc[mt][nt] = MFMA16(a[ks][mt], bf, acc[mt][nt]);
                if (nt == 7) asm volatile("" ::: "memory"); }
#pragma unroll
        for (int ntl = 0; ntl < 4; ++ntl) { const int k1 = 16 * ntl + fr; float ore[8], oim[8];
#pragma unroll
            for (int e = 0; e < 8; ++e) { const int n2 = n2_0 + 32 * a2 + 8 * fq + e;
                const float re = acc[e >> 2][ntl][e & 3], im = acc[e >> 2][ntl + 4][e & 3];
                const float ang = (float)((n2 * k1) & 8191) * (1.0f / 8192.0f);
                const float cs = __builtin_amdgcn_cosf(ang), sn = __builtin_amdgcn_sinf(ang);
                ore[e] = re * cs + im * sn; oim[e] = im * cs - re * sn; }
            bf16_t* o = t1 + ((size_t)(((b * 4 + g) * 128 + c) * 2) * 64 + k1) * 128 + n2_0 + 32 * a2 + 8 * fq;
            u32x4 w; w.x = pk2(ore[0], ore[1]); w.y = pk2(ore[2], ore[3]); w.z = pk2(ore[4], ore[5]); w.w = pk2(ore[6], ore[7]);
            *(u32x4*)o = w;
            w.x = pk2(oim[0], oim[1]); w.y = pk2(oim[2], oim[3]); w.z = pk2(oim[4], oim[5]); w.w = pk2(oim[6], oim[7]);
            *(u32x4*)(o + 64 * 128) = w; }
    }
}
DI void fft2_item(const bf16_t* t1, bf16_t* y, const LAS unsigned char* cb, int item, int lane) {
    const int chh = item & 1, k1 = (item >> 1) & 63, g = (item >> 7) & 3, b = item >> 9;
    const int fr = lane & 15, fq = lane >> 4;
#pragma unroll 1
    for (int a2 = 0; a2 < 2; ++a2) {
        f32x4 acc[2][8];
#pragma unroll
        for (int mt = 0; mt < 2; ++mt)
#pragma unroll
            for (int nt = 0; nt < 8; ++nt) acc[mt][nt] = (f32x4){0.f, 0.f, 0.f, 0.f};
#pragma unroll
        for (int kh = 0; kh < 2; ++kh) {
            bf16x8 a[4][2];
#pragma unroll
            for (int kq = 0; kq < 4; ++kq) { const int n2_0 = 32 * kq + 8 * fq;
#pragma unroll
                for (int mt = 0; mt < 2; ++mt) { const int c = 64 * chh + 32 * a2 + 8 * (fr >> 2) + 4 * mt + (fr & 3);
                    a[kq][mt] = __builtin_nontemporal_load((const bf16x8*)(t1 + ((size_t)((((b * 4 + g) * 128 + c) * 2 + kh) * 64 + k1)) * 128 + n2_0)); } }
#pragma unroll
            for (int kq = 0; kq < 4; ++kq)
#pragma unroll
                for (int nt = 0; nt < 8; ++nt) { const bf16x8 bf = *(const LAS bf16x8*)(cb + (((kh * 4 + kq) * 8 + nt) * 64 + lane) * 16);
#pragma unroll
                    for (int mt = 0; mt < 2; ++mt) acc[mt][nt] = MFMA16(a[kq][mt], bf, acc[mt][nt]);
                    if (nt == 7) asm volatile("" ::: "memory"); }
        }
#pragma unroll
        for (int nt = 0; nt < 8; ++nt) { const int k2 = 16 * nt + fr; const size_t tok = (size_t)b * 8192 + k1 + 64 * k2;
            const f32x4 v0 = acc[0][nt], v1 = acc[1][nt];
            u32x4 w; w.x = pk2(v0[0], v0[1]); w.y = pk2(v0[2], v0[3]); w.z = pk2(v1[0], v1[1]); w.w = pk2(v1[2], v1[3]);
            *(u32x4*)(y + tok * 512 + g * 128 + 64 * chh + 32 * a2 + 8 * fq) = w; }
    }
}

DI void dma16(const void* gsrc, LAS unsigned char* lds_wave_base) { __builtin_amdgcn_global_load_lds((const unsigned*)gsrc, (LAS unsigned*)lds_wave_base, 16, 0, 0); }
constexpr int NA_KOFF = 0, NA_VOFF = 57344, NA_RPB = 114688, NA_UNITS = 2048;
struct NaUnit { int b, h, s, chf, rb, kc0; };
DI NaUnit na_decode(int uid) { NaUnit u; u.chf = uid & 1; u.s = (uid >> 1) & 31; u.h = (uid >> 6) & 7; u.b = uid >> 9; u.rb = min(max(4 * u.s - 4, 0), 120); u.kc0 = u.chf ? 24 : 0; return u; }
DI void na_stage_k(const NaUnit& u, const bf16_t* k, LAS unsigned char* lds, int wave, int lane) {
    for (int p = wave; p < 55; p += 8) { const int P = p * 64 + lane, j = P / 320, rem = P - j * 320, kl = rem >> 3, cpos = rem & 7, chunk = cpos ^ ((kl >> 1) & 7);
        const int row = min(u.rb + j, 127);
        dma16(k + blk_off(u.b * 8192 + row * 64 + u.kc0 + kl, u.h * 64 + 8 * chunk, 512), lds + NA_KOFF + p * 1024); }
}
DI void na_stage_v(const NaUnit& u, const bf16_t* vt, LAS unsigned char* lds, int wave, int lane) {
    for (int p = wave; p < 55; p += 8) { const int P = p * 64 + lane, rowid = P / 5, c5 = P - rowid * 5, j = rowid >> 6, d = rowid & 63;
        const int row = min(u.rb + j, 127);
        dma16(vt + blk_off(u.b * 512 + u.h * 64 + d, row * 64 + u.kc0 + 8 * c5, 8192), lds + NA_VOFF + p * 1024); }
}
DI void na_phase(const Frame& F, const bf16_t* q, const bf16_t* k, const bf16_t* vt, bf16_t* o) {
    LAS unsigned char* lds = F.lds; const LAS float* rpbl = (const LAS float*)(F.lds + NA_RPB);
    const int lane = F.lane, w = F.wave, fr = lane & 15, fq = lane >> 4;
    const bool bal = (F.G == 256); const int vm = F.vcu & 15;
    const int nun = !bal ? 8 : (vm == 0 ? 5 : ((vm & 3) == 0 ? 9 : 8));
    const int extra = (F.vcu & ~15) + (5 + (vm >> 2) - 1) * 256;
    int ui = 0, uid = F.vcu;
    if (uid >= NA_UNITS) return;
    NaUnit u = na_decode(uid);
    na_stage_k(u, k, lds, w, lane);
    bf16x8 qf[2];
    { const int r = 4 * u.s + (w >> 1), jb = 2 * u.chf + (w & 1); const int tq = u.b * 8192 + r * 64 + 16 * jb + fr;
#pragma unroll
      for (int ks = 0; ks < 2; ++ks) qf[ks] = __builtin_nontemporal_load((const bf16x8*)(q + blk_off(tq, u.h * 64 + 32 * ks + 8 * fq, 512))); }
    VM_WAIT(); __syncthreads();
    for (;;) {
        na_stage_v(u, vt, lds, w, lane);
        const int r = 4 * u.s + (w >> 1), jb = 2 * u.chf + (w & 1);
        const int rs = min(max(r - 4, 0), 120), j0 = rs - u.rb;
        const int w0 = jb == 0 ? 0 : (jb == 1 ? 8 : (jb == 2 ? 24 : 32)), wl = w0 - u.kc0;
        const size_t tokq = (size_t)u.b * 8192 + r * 64 + 16 * jb + fr;
        f32x4 s[8][2];
#pragma unroll
        for (int i = 0; i < 8; ++i)
#pragma unroll
            for (int ch = 0; ch < 2; ++ch) { const int kl = wl + 16 * ch + fr, sw = (kl >> 1) & 7;
                const LAS unsigned char* kb = lds + NA_KOFF + ((j0 + i) * 40 + kl) * 128;
                const bf16x8 k0 = *(const LAS bf16x8*)(kb + ((fq ^ sw) * 16)), k1 = *(const LAS bf16x8*)(kb + (((4 + fq) ^ sw) * 16));
                f32x4 z = (f32x4){0.f, 0.f, 0.f, 0.f};
                z = MFMA16(k0, qf[0], z); s[i][ch] = MFMA16(k1, qf[1], z); }
        const int c = 16 * jb + fr, cs = min(max(c - 8, 0), 48), wofs = cs - w0;
        bool c0[4]; int dcs[4];
#pragma unroll
        for (int rr = 0; rr < 4; ++rr) { c0[rr] = (4 * fq + rr) >= wofs; dcs[rr] = (w0 + 4 * fq + rr + (c0[rr] ? 0 : 16)) - c + 15; }
        float mx = -1e30f;
#pragma unroll
        for (int i = 0; i < 8; ++i) { const LAS float* brow = rpbl + u.h * 480 + (rs + i - r + 7) * 32;
#pragma unroll
            for (int rr = 0; rr < 4; ++rr) { const float v = (c0[rr] ? s[i][0][rr] : s[i][1][rr]) + brow[dcs[rr]]; s[i][0][rr] = v; mx = fmaxf(mx, v); } }
        mx = fmaxf(mx, __shfl_xor(mx, 16)); mx = fmaxf(mx, __shfl_xor(mx, 32));
        float l = 0.f;
        u32x4 pw[8];
#pragma unroll
        for (int i = 0; i < 8; ++i) { float p[4];
#pragma unroll
            for (int rr = 0; rr < 4; ++rr) { p[rr] = __builtin_amdgcn_exp2f(s[i][0][rr] - mx); l += p[rr]; }
            pw[i].x = pk2(c0[0] ? p[0] : 0.f, c0[1] ? p[1] : 0.f); pw[i].y = pk2(c0[2] ? p[2] : 0.f, c0[3] ? p[3] : 0.f);
            pw[i].z = pk2(c0[0] ? 0.f : p[0], c0[1] ? 0.f : p[1]); pw[i].w = pk2(c0[2] ? 0.f : p[2], c0[3] ? 0.f : p[3]); }
        l += __shfl_xor(l, 16); l += __shfl_xor(l, 32);
        const float inv = 1.0f / l;
        VM_WAIT(); __syncthreads();
        ++ui; const int nuid = !bal ? uid + F.G : (ui < 8 ? F.vcu + 256 * ui : extra); const bool has_next = !bal ? (nuid < NA_UNITS) : (ui < nun);
        NaUnit nu = u;
        if (has_next) { nu = na_decode(nuid); na_stage_k(nu, k, lds, w, lane);
            const int nr = 4 * nu.s + (w >> 1), njb = 2 * nu.chf + (w & 1); const int tq = nu.b * 8192 + nr * 64 + 16 * njb + fr;
#pragma unroll
            for (int ks = 0; ks < 2; ++ks) qf[ks] = __builtin_nontemporal_load((const bf16x8*)(q + blk_off(tq, nu.h * 64 + 32 * ks + 8 * fq, 512))); }
        f32x4 oacc[4];
#pragma unroll
        for (int dt = 0; dt < 4; ++dt) oacc[dt] = (f32x4){0.f, 0.f, 0.f, 0.f};
#pragma unroll
        for (int i = 0; i < 8; ++i) { const bf16x8 pf = __builtin_bit_cast(bf16x8, pw[i]);
#pragma unroll
            for (int dt = 0; dt < 4; ++dt) { const LAS unsigned char* vb = lds + NA_VOFF + ((j0 + i) * 64 + 16 * dt + fr) * 80 + (wl + 4 * fq) * 2;
                const u32x2 lo = *(const LAS u32x2*)vb, hi = *(const LAS u32x2*)(vb + 32);
                u32x4 vw; vw.x = lo.x; vw.y = lo.y; vw.z = hi.x; vw.w = hi.y;
                oacc[dt] = MFMA16(__builtin_bit_cast(bf16x8, vw), pf, oacc[dt]); } }
        asm volatile("s_waitcnt vmcnt(0)" ::: "memory");
#pragma unroll
        for (int dt = 0; dt < 4; ++dt) { u32x2 wv; wv.x = pk2(oacc[dt][0] * inv, oacc[dt][1] * inv); wv.y = pk2(oacc[dt][2] * inv, oacc[dt][3] * inv);
            *(u32x2*)(o + tokq * 512 + u.h * 64 + 16 * dt + 4 * fq) = wv; }
        asm volatile("s_waitcnt lgkmcnt(0)" ::: "memory"); __builtin_amdgcn_s_barrier(); asm volatile("" ::: "memory");
        if (!has_next) break;
        uid = nuid; u = nu;
    }
    VM_WAIT(); __syncthreads();
}
DI void mem_phase(const Frame& F, const bf16_t* qm, const bf16_t* km, const bf16_t* vtm, bf16_t* o) {
    LAS unsigned char* lds = F.lds; const int lane = F.lane, w = F.wave, fr = lane & 15, fq = lane >> 4;
    if (F.tid == 0) { unsigned* cnt = (unsigned*)(F.ws + WS_CTL) + CW_KVDONE; unsigned* tmo = (unsigned*)(F.ws + WS_CTL) + CW_BAR + XB_TMO; unsigned sp = 0;
        while (xb_ld(cnt) < 16u) { __builtin_amdgcn_s_sleep(2); if ((++sp & 255u) == 0u) { if (xb_ld(tmo)) break; if (sp > (1u << 20)) { atomicAdd(tmo, 1u); break; } } }
        __builtin_amdgcn_fence(__ATOMIC_ACQUIRE, "agent"); asm volatile("s_waitcnt vmcnt(0)" ::: "memory"); }
    __syncthreads();
    for (int chunk = F.vcu; chunk < 256; chunk += F.G) {
        const int pair = chunk >> 4, b = pair >> 2, h = pair & 3, qc = chunk & 15;
        for (int i = 0; i < 8; ++i) { const int p = w + 8 * i, P = p * 64 + lane;
            { const int key = P >> 4, cpos = P & 15, c = cpos ^ (key & 15); dma16(km + blk_off(b * 256 + key, h * 128 + 8 * c, 512), lds + p * 1024); }
            { const int d = P >> 5, cpos = P & 31, c = cpos ^ (d & 15); dma16(vtm + blk_off(b * 512 + h * 128 + d, 8 * c, 256), lds + 65536 + p * 1024); } }
        VM_WAIT(); __syncthreads();
#pragma unroll 1
        for (int pass = 0; pass < 4; ++pass) {
            asm volatile("" ::: "memory");
            const size_t tokq = (size_t)b * 8192 + qc * 512 + w * 64 + pass * 16 + fr;
            bf16x8 qf[4];
#pragma unroll
            for (int ks = 0; ks < 4; ++ks) qf[ks] = __builtin_nontemporal_load((const bf16x8*)(qm + blk_off((int)tokq, h * 128 + 32 * ks + 8 * fq, 512)));
            f32x4 s[16];
#pragma unroll
            for (int kt = 0; kt < 16; ++kt) { const LAS unsigned char* kb = lds + (16 * kt + fr) * 256;
                f32x4 z0 = (f32x4){0.f, 0.f, 0.f, 0.f};
#pragma unroll
                for (int ks = 0; ks < 4; ++ks) { const bf16x8 kf = *(const LAS bf16x8*)(kb + (((4 * ks + fq) ^ fr) * 16)); z0 = MFMA16(kf, qf[ks], z0); }
                s[kt] = z0; if ((kt & 3) == 3) asm volatile("" ::: "memory"); }
            u32x4 pw[8];
            float mx = -1e30f;
#pragma unroll
            for (int kt = 0; kt < 16; ++kt)
#pragma unroll
                for (int rr = 0; rr < 4; ++rr) mx = fmaxf(mx, s[kt][rr]);
            mx = fmaxf(mx, __shfl_xor(mx, 16)); mx = fmaxf(mx, __shfl_xor(mx, 32));
            float l = 0.f;
#pragma unroll
            for (int u = 0; u < 8; ++u) { float p[8];
#pragma unroll
                for (int e = 0; e < 8; ++e) { p[e] = __builtin_amdgcn_exp2f(s[2 * u + (e >> 2)][e & 3] - mx); l += p[e]; }
                pw[u].x = pk2(p[0], p[1]); pw[u].y = pk2(p[2], p[3]); pw[u].z = pk2(p[4], p[5]); pw[u].w = pk2(p[6], p[7]); }
            l += __shfl_xor(l, 16); l += __shfl_xor(l, 32);
            const float inv = 1.0f / l;
            f32x4 oacc[8];
#pragma unroll
            for (int dt = 0; dt < 8; ++dt) oacc[dt] = (f32x4){0.f, 0.f, 0.f, 0.f};
#pragma unroll
            for (int u = 0; u < 8; ++u)
#pragma unroll
                for (int dt = 0; dt < 8; ++dt) { const LAS unsigned char* vb = lds + 65536 + (16 * dt + fr) * 512;
                    const u32x2 lo = *(const LAS u32x2*)(vb + (((8 * u + fq) ^ (fr << 1)) * 8)), hi = *(const LAS u32x2*)(vb + (((8 * u + 4 + fq) ^ (fr << 1)) * 8));
                    u32x4 vw; vw.x = lo.x; vw.y = lo.y; vw.z = hi.x; vw.w = hi.y;
                    oacc[dt] = MFMA16(__builtin_bit_cast(bf16x8, vw), __builtin_bit_cast(bf16x8, pw[u]), oacc[dt]);
                    if (dt == 7) asm volatile("" ::: "memory"); }
#pragma unroll
            for (int dt = 0; dt < 8; ++dt) { u32x2 wv; wv.x = pk2(oacc[dt][0] * inv, oacc[dt][1] * inv); wv.y = pk2(oacc[dt][2] * inv, oacc[dt][3] * inv);
                *(u32x2*)(o + tokq * 512 + h * 128 + 16 * dt + 4 * fq) = wv; }
        }
        __syncthreads();
    }
}

DI void p7_stage_wr(const bf16_t* wrt, LAS unsigned char* lds, int half, int w, int lane) {
    for (int i = 0; i < 10; ++i) { const int p = w + 8 * i, P = p * 64 + lane, row = P >> 6, cpos = P & 63, c = (cpos & ~15) | ((cpos ^ row) & 15);
        dma16(wrt + (size_t)row * 1024 + half * 512 + 8 * c, lds + p * 1024); }
}
DI void p6_ln_router(const Frame& F, const Args& a) {
    unsigned char* ws = F.ws; const int lane = F.lane, w = F.wave, fr = lane & 15, fq = lane >> 4;
    const bf16_t* v = (const bf16_t*)(ws + WS_V); bf16_t* h = (bf16_t*)(ws + WS_H); const bf16_t* wrt = (const bf16_t*)(ws + WS_WRT);
    unsigned* gcnt = (unsigned*)(ws + WS_CTL) + CW_GCNT; int* list = (int*)(ws + WS_LIST); unsigned* rec = (unsigned*)(ws + WS_REC);
    LAS unsigned char* lds = F.lds;
    LAS float* lg = (LAS float*)(F.lds + 81920 + w * 5120);
    LAS float* gbl = (LAS float*)(F.lds + 122880);
    LAS int* hist = (LAS int*)(F.lds + MISC_OFF + MS_HIST); LAS int* base = (LAS int*)(F.lds + MISC_OFF + MS_BASE);
    for (int i = F.tid; i < 1024; i += 512) { gbl[i] = a.in[IN_LN1G][i]; gbl[1024 + i] = a.in[IN_LN1B][i]; }
    for (int chunk = F.vcu; chunk < T / 128; chunk += F.G) {
        const int tok0 = chunk * 128 + 16 * w;
        if (F.tid < 64) hist[F.tid] = 0;
        __syncthreads();
        p7_stage_wr(wrt, lds, 0, w, lane);
        { const bf16_t* vb = v + (size_t)(tok0 >> 4) * 32 * 512 + lane * 8;
          float s = 0.f, q = 0.f;
#pragma unroll 1
          for (int grp = 0; grp < 2; ++grp) { u32x4 d[16];
#pragma unroll
              for (int b = 0; b < 16; ++b) d[b] = __builtin_nontemporal_load((const u32x4*)(vb + (grp * 16 + b) * 512));
#pragma unroll
              for (int b = 0; b < 16; ++b) { const unsigned wd[4] = {d[b].x, d[b].y, d[b].z, d[b].w};
#pragma unroll
                  for (int j = 0; j < 4; ++j) { const float x0 = bf_lo(wd[j]), x1 = bf_hi(wd[j]); s += x0 + x1; q += x0 * x0 + x1 * x1; } } }
          s += __shfl_xor(s, 1); s += __shfl_xor(s, 2); q += __shfl_xor(q, 1); q += __shfl_xor(q, 2);
          const float mean = s * (1.0f / 1024.0f);
          const float rstd = 1.0f / sqrtf(fmaxf(q * (1.0f / 1024.0f) - mean * mean, 0.f) + LN_EPS);
          bf16_t* hrow = h + (size_t)(tok0 + (lane >> 2)) * 1024 + 8 * (lane & 3);
#pragma unroll 1
          for (int grp = 0; grp < 2; ++grp) { u32x4 d[16];
              asm volatile("" ::: "memory");
#pragma unroll
              for (int b = 0; b < 16; ++b) d[b] = __builtin_nontemporal_load((const u32x4*)(vb + (grp * 16 + b) * 512));
#pragma unroll
              for (int b = 0; b < 16; ++b) { const int col = 32 * (grp * 16 + b) + 8 * (lane & 3);
                  const f32x4 g0 = *(const LAS f32x4*)(gbl + col), g1 = *(const LAS f32x4*)(gbl + col + 4), b0 = *(const LAS f32x4*)(gbl + 1024 + col), b1 = *(const LAS f32x4*)(gbl + 1024 + col + 4);
                  u32x4 o;
                  o.x = pk2((bf_lo(d[b].x) - mean) * rstd * g0[0] + b0[0], (bf_hi(d[b].x) - mean) * rstd * g0[1] + b0[1]);
                  o.y = pk2((bf_lo(d[b].y) - mean) * rstd * g0[2] + b0[2], (bf_hi(d[b].y) - mean) * rstd * g0[3] + b0[3]);
                  o.z = pk2((bf_lo(d[b].z) - mean) * rstd * g1[0] + b1[0], (bf_hi(d[b].z) - mean) * rstd * g1[1] + b1[1]);
                  o.w = pk2((bf_lo(d[b].w) - mean) * rstd * g1[2] + b1[2], (bf_hi(d[b].w) - mean) * rstd * g1[3] + b1[3]);
                  *(u32x4*)(hrow + 32 * (grp * 16 + b)) = o; if ((b & 3) == 3) asm volatile("" ::: "memory"); } } }
        VM_WAIT(); __syncthreads();
        f32x4 acc[5];
#pragma unroll
        for (int mt = 0; mt < 5; ++mt) acc[mt] = (f32x4){0.f, 0.f, 0.f, 0.f};
        const bf16_t* hb = h + (size_t)(tok0 + fr) * 1024 + 8 * fq;
#pragma unroll 1
        for (int half = 0; half < 2; ++half) {
            if (half) { __syncthreads(); p7_stage_wr(wrt, lds, 1, w, lane); VM_WAIT(); __syncthreads(); }
#pragma unroll 4
            for (int ks = 0; ks < 16; ++ks) { const bf16x8 bfr = *(const bf16x8*)(hb + half * 512 + 32 * ks); const int ch = 4 * ks + fq, cpos = (ch & ~15) | ((ch ^ fr) & 15);
#pragma unroll
                for (int mt = 0; mt < 5; ++mt) acc[mt] = MFMA16(*(const LAS bf16x8*)(lds + (16 * mt + fr) * 1024 + cpos * 16), bfr, acc[mt]);
                asm volatile("" ::: "memory"); }
        }
#pragma unroll
        for (int mt = 0; mt < 5; ++mt)
#pragma unroll
            for (int rr = 0; rr < 4; ++rr) lg[fr * 80 + 16 * mt + 4 * fq + rr] = acc[mt][rr];
        LDS_WAIT(); asm volatile("" ::: "memory");
        int e1 = 0, e2 = 0, l1 = 0, l2 = 0; float w1 = 0.f, w2 = 0.f;
        if (lane < 16) {
            const LAS float* L = lg + lane * 80;
            float gl[8]; int gi = 0; float gm;
#pragma unroll
            for (int j = 0; j < 8; ++j) gl[j] = L[64 + j] + a.in[IN_BRG][j];
            gm = gl[0];
#pragma unroll
            for (int j = 1; j < 8; ++j) if (gl[j] > gm) { gm = gl[j]; gi = j; }
            float se = 0.f;
#pragma unroll
            for (int j = 0; j < 8; ++j) se += __expf(gl[j] - gm);
            const float pg = 1.0f / se;
            float el[8];
#pragma unroll
            for (int j = 0; j < 8; ++j) el[j] = L[gi * 8 + j] + a.in[IN_BRE][gi * 8 + j];
            int i1 = 0; float v1 = el[0];
#pragma unroll
            for (int j = 1; j < 8; ++j) if (el[j] > v1) { v1 = el[j]; i1 = j; }
            int i2 = -1; float v2 = -3.0e38f;
#pragma unroll
            for (int j = 0; j < 8; ++j) if (j != i1 && el[j] > v2) { v2 = el[j]; i2 = j; }
            const float t = __expf(v2 - v1); const float p1 = 1.0f / (1.0f + t);
            w1 = p1 * pg; w2 = (t * p1) * pg; e1 = gi * 8 + i1; e2 = gi * 8 + i2;
            l1 = __hip_atomic_fetch_add(&hist[e1], 1, __ATOMIC_RELAXED, __HIP_MEMORY_SCOPE_WORKGROUP); l2 = __hip_atomic_fetch_add(&hist[e2], 1, __ATOMIC_RELAXED, __HIP_MEMORY_SCOPE_WORKGROUP);
        }
        __syncthreads();
        if (F.tid < 64) { const int c = hist[F.tid]; base[F.tid] = c > 0 ? (int)atomicAdd(gcnt + F.tid, (unsigned)c) : 0; }
        __syncthreads();
        if (lane < 16) { const int tok = tok0 + lane; const int s1 = base[e1] + l1, s2 = base[e2] + l2;
            if (s1 < LIST_CAP) list[(size_t)e1 * LIST_CAP + s1] = tok;
            if (s2 < LIST_CAP) list[(size_t)e2 * LIST_CAP + s2] = tok;
            u32x4 r0; r0.x = (unsigned)e1; r0.y = (unsigned)s1; r0.z = (unsigned)e2; r0.w = (unsigned)s2;
            *(u32x4*)(rec + (size_t)tok * 8) = r0;
            u32x2 r1; r1.x = __float_as_uint(w1); r1.y = __float_as_uint(w2); *(u32x2*)(rec + (size_t)tok * 8 + 4) = r1; }
        __syncthreads();
    }
}

DI void p9_combine(const Frame& F, const Args& a) {
    unsigned char* ws = F.ws; const int lane = F.lane;
    const bf16_t* h = (const bf16_t*)(ws + WS_H); const bf16_t* yb = (const bf16_t*)(ws + WS_YB); const unsigned* rec = (const unsigned*)(ws + WS_REC);
    const LAS int* tstart = (const LAS int*)(F.lds + MISC_OFF + MS_TSTART);
    f32x4 gv[4], bv[4];
#pragma unroll
    for (int j = 0; j < 4; ++j) { gv[j] = *(const f32x4*)(a.in[IN_LN2G] + 4 * lane + 256 * j); bv[j] = *(const f32x4*)(a.in[IN_LN2B] + 4 * lane + 256 * j); }
    const int gw = F.vcu * 8 + F.wave, NGW = F.G * 8;
    for (int t = gw; t < T; t += NGW) {
        const u32x4 r0 = *(const u32x4*)(rec + (size_t)t * 8); const u32x2 r1 = *(const u32x2*)(rec + (size_t)t * 8 + 4);
        const size_t row1 = (size_t)tstart[r0.x] * 256 + r0.y, row2 = (size_t)tstart[r0.z] * 256 + r0.w;
        const float w1 = __uint_as_float(r1.x), w2 = __uint_as_float(r1.y);
        f32x4 x[4]; float s = 0.f;
#pragma unroll
        for (int j = 0; j < 4; ++j) { const int col = 4 * lane + 256 * j;
            const u32x2 hv = __builtin_nontemporal_load((const u32x2*)(h + (size_t)t * 1024 + col)), y1 = __builtin_nontemporal_load((const u32x2*)(yb + blk_off((int)row1, col, 1024))), y2 = __builtin_nontemporal_load((const u32x2*)(yb + blk_off((int)row2, col, 1024)));
            x[j][0] = ALPHA * bf_lo(hv.x) + w1 * bf_lo(y1.x) + w2 * bf_lo(y2.x); x[j][1] = ALPHA * bf_hi(hv.x) + w1 * bf_hi(y1.x) + w2 * bf_hi(y2.x);
            x[j][2] = ALPHA * bf_lo(hv.y) + w1 * bf_lo(y1.y) + w2 * bf_lo(y2.y); x[j][3] = ALPHA * bf_hi(hv.y) + w1 * bf_hi(y1.y) + w2 * bf_hi(y2.y);
            s += (x[j][0] + x[j][1]) + (x[j][2] + x[j][3]); }
        const float mean = wave_sum(s) * (1.0f / 1024.0f); float s2 = 0.f;
#pragma unroll
        for (int j = 0; j < 4; ++j) { x[j] = x[j] - mean; s2 += (x[j][0] * x[j][0] + x[j][1] * x[j][1]) + (x[j][2] * x[j][2] + x[j][3] * x[j][3]); }
        const float rstd = 1.0f / sqrtf(wave_sum(s2) * (1.0f / 1024.0f) + LN_EPS);
#pragma unroll
        for (int j = 0; j < 4; ++j) __builtin_nontemporal_store(x[j] * rstd * gv[j] + bv[j], (f32x4*)(a.out + (size_t)t * 1024 + 4 * lane + 256 * j));
    }
}

constexpr int N_PHASES = 11;
__global__ void __launch_bounds__(512, 2) mk_fwd(Args args) {
    extern __shared__ __attribute__((aligned(16))) unsigned char lds_raw[];
    Frame F;
    F.lds = (LAS unsigned char*)lds_raw;
    F.tid = threadIdx.x; F.lane = F.tid & 63; F.wave = __builtin_amdgcn_readfirstlane(F.tid >> 6);
    F.G = gridDim.x; { const int bx = blockIdx.x; F.vcu = (F.G % 8 == 0) ? (bx % 8) * (F.G / 8) + bx / 8 : bx; }
    F.ws = args.ws;
    unsigned char* ws = args.ws;
    for (int u = F.tid; u < (LDS_BYTES - MISC_OFF) / 4; u += 512) ((LAS unsigned*)(F.lds + MISC_OFF))[u] = 0u;
    __syncthreads();
    const int lo = args.ph_lo, hi = args.ph_hi;
    XcdBarrier bar; bar.bar = (unsigned*)(ws + WS_CTL) + CW_BAR; bar.x = 0; bar.st = nullptr;
    if (hi - lo > 1) bar = xcd_barrier_post((unsigned*)(ws + WS_CTL) + CW_BAR, (volatile LAS unsigned*)(F.lds + MISC_OFF + MS_BAR));
#ifndef PH_MASK
#define PH_MASK 0xffff
#endif
#ifndef PROBE_TWICE
#define PROBE_TWICE -1
#endif
#define IN(k) (((PH_MASK >> (k)) & 1) && lo <= (k) && (k) < hi)
#define REP(k) for (int rep_ = 0; rep_ < ((k) == PROBE_TWICE ? 2 : 1); ++rep_)
#define SEAM(k) do { if (IN(k) && IN((k) + 1)) xcd_barrier(bar); } while (0)
    const int cid = (int)blockIdx.x;

    if (IN(0)) REP(0) { p0_prologue(F, args); }
    SEAM(0);
    if (IN(1)) REP(1) {
        { SchedP1F S{1024, F.G, cid, (const char*)(ws + WS_XB), (const char*)(ws + WS_W1T)}; EpiP1<false> E{ws, args.in[IN_BGATE]};
          pg8::gemm_phase<EpiP1<false>, SchedP1F>(F.lds, S, E); }
        { SchedP1g S{1024, F.G, cid, (const char*)(ws + WS_XB), (const char*)(ws + WS_W1T)}; EpiP1<true> E{ws, args.in[IN_BGATE]};
          pg8::gemm_phase<EpiP1<true>, SchedP1g>(F.lds, S, E); }
        { SchedP1a S{1024, F.G, cid, (const char*)(ws + WS_XB), (const char*)(ws + WS_W1T), (const char*)(ws + WS_MEMB), (const char*)(ws + WS_WKVT)}; EpiP1<false> E{ws, args.in[IN_BGATE]};
          pg8::gemm_phase<EpiP1<false>, SchedP1a>(F.lds, S, E); }
    }
    SEAM(1);
    if (IN(2)) REP(2) {
        __syncthreads();
        const int gw = F.vcu * 8 + F.wave, NGW = F.G * 8;
        { const int kvj = (F.G == 256) ? ((F.vcu & 15) == 0 ? (F.vcu >> 4) : -1) : (F.vcu < 16 ? F.vcu : -1);
          SchedKV S{1024, kvj, (const char*)(ws + WS_MEMB), (const char*)(ws + WS_WKVT)}; EpiP1<false> E{ws, args.in[IN_BGATE]};
          pg8::gemm_phase<EpiP1<false>, SchedKV>(F.lds, S, E);
          if (kvj >= 0) { VM_WAIT(); __syncthreads();
              if (F.tid == 0) { __builtin_amdgcn_fence(__ATOMIC_RELEASE, "agent"); asm volatile("s_waitcnt vmcnt(0)" ::: "memory"); (void)xb_add((unsigned*)(ws + WS_CTL) + CW_KVDONE, 1u); }
              __syncthreads(); } }
        { LAS unsigned char* fb = F.lds;
          for (int i = F.tid; i < 2048; i += 512) *(LAS u32x4*)(fb + i * 16) = *(const u32x4*)(ws + WS_F64 + (size_t)i * 16);
          __syncthreads();
          for (int it = gw; it < 4096; it += NGW) fft1_item((const bf16_t*)(ws + WS_ZT), (bf16_t*)(ws + WS_T1), fb, it, F.lane);
          __syncthreads(); }
        { LAS float* rpbl = (LAS float*)(F.lds + NA_RPB);
          for (int i = F.tid; i < 8 * 15 * 32; i += 512) { const int dc = i & 31, dr = (i >> 5) % 15, hh = i / 480; rpbl[i] = dc < 31 ? args.in[IN_RPB][(hh * 15 + dr) * 31 + dc] * 1.4426950408889634f : 0.f; }
          __syncthreads();
          na_phase(F, (const bf16_t*)(ws + WS_Q), (const bf16_t*)(ws + WS_K), (const bf16_t*)(ws + WS_VT), (bf16_t*)(ws + WS_ONA)); }
        mem_phase(F, (const bf16_t*)(ws + WS_QM), (const bf16_t*)(ws + WS_KVM), (const bf16_t*)(ws + WS_KVM + MiB), (bf16_t*)(ws + WS_OMEM));
    }
    SEAM(2);
    if (IN(3)) REP(3) {
        LAS unsigned char* cb = F.lds;
        for (int i = F.tid; i < 4096; i += 512) *(LAS u32x4*)(cb + i * 16) = *(const u32x4*)(ws + WS_C128 + (size_t)i * 16);
        __syncthreads();
        const int gw = F.vcu * 8 + F.wave, NGW = F.G * 8;
        for (int it = gw; it < 2048; it += NGW) fft2_item((const bf16_t*)(ws + WS_T1), (bf16_t*)(ws + WS_Y), cb, it, F.lane);
        __syncthreads();
    }
    SEAM(3);
    if (IN(4)) REP(4) {
        SchedMerge S{512, F.G, cid, (const char*)(ws + WS_Y), (const char*)(ws + WS_WFOT)};
        EpiMerge E{(const bf16_t*)(ws + WS_GATES), (bf16_t*)(ws + WS_MERGED)};
        pg8::gemm_phase<EpiMerge, SchedMerge>(F.lds, S, E);
    }
    SEAM(4);
    if (IN(5)) REP(5) {
        const bool cvt_first = (F.vcu & 1) != 0;
        if (cvt_first) p_expert_cvt_gu(F, args);
        __syncthreads();
        { SchedOut S{1024, F.G, cid, (const char*)(ws + WS_MERGED), (const char*)(ws + WS_WOUTT)}; EpiOut E{args.in[IN_X], (bf16_t*)(ws + WS_V)};
          pg8::gemm_phase<EpiOut, SchedOut>(F.lds, S, E); }
        __syncthreads();
        if (!cvt_first) p_expert_cvt_gu(F, args);
    }
    SEAM(5);
    if (IN(6)) { }
    if (IN(6) && IN(7)) { }
    if (IN(7)) { p6_ln_router(F, args); }
    SEAM(7);
    if (IN(8)) REP(8) {
        moe_tables(F);
        SchedMoeGU S{1024, F.G, cid, (const char*)(ws + WS_H), (const char*)(ws + WS_WGUT), (const int*)(ws + WS_LIST), F.lds + MISC_OFF}; EpiSwiGLU E{(bf16_t*)(ws + WS_HMOE)};
        pg8::gemm_phase<EpiSwiGLU, SchedMoeGU>(F.lds, S, E);
        __syncthreads();
        if (F.G >= 2) { if (cid >= F.G / 2) p_expert_cvt_down(F, args, cid - F.G / 2, F.G - F.G / 2); } else p_expert_cvt_down(F, args, 0, 1);
    }
    SEAM(8);
    if (IN(9)) REP(9) {
        moe_tables(F);
        SchedMoeD S{512, F.G, cid, (const char*)(ws + WS_HMOE), (const char*)(ws + WS_WDT), F.lds + MISC_OFF}; EpiDown E{(bf16_t*)(ws + WS_YB)};
        pg8::gemm_phase<EpiDown, SchedMoeD>(F.lds, S, E);
    }
    SEAM(9);
    if (IN(10)) REP(10) { moe_tables(F); p9_combine(F, args); }
#ifdef PROBE_SEL
    __syncthreads();
    if (blockIdx.x == PROBE_BLOCK && F.tid == 0) { const unsigned long long d = *(LAS unsigned long long*)(F.lds + MISC_OFF + 3072) * PROBE_SCALE; const unsigned long long t0 = __builtin_amdgcn_s_memrealtime();
        while (__builtin_amdgcn_s_memrealtime() - t0 < d) __builtin_amdgcn_s_sleep(16); }
#endif
#undef IN
#undef SEAM
#undef REP
}

#ifndef MK_PER_PHASE
#define MK_PER_PHASE 0
#endif
extern "C" void kernel_launch(void* const* d_in, const int* in_sizes, int n_in, void* d_out, int out_size, void* d_ws, size_t ws_size, hipStream_t stream) {
    static int grid = 0;
    if (grid == 0) {
        if (n_in != 22 || in_sizes[0] != T * DM || out_size != T * DM || ws_size < WS_END) {
            fprintf(stderr, "kernel_launch: unexpected problem (n_in %d, in0 %d, out %d, ws %zu < %zu); nothing launched\n", n_in, n_in > 0 ? in_sizes[0] : -1, out_size, ws_size, (size_t)WS_END); grid = -1; return; }
        int dev = 0, cus = 0, per_cu = 0;
        if (hipGetDevice(&dev) != hipSuccess || hipDeviceGetAttribute(&cus, hipDeviceAttributeMultiprocessorCount, dev) != hipSuccess) { grid = -1; return; }
        if (hipFuncSetAttribute((const void*)mk_fwd, hipFuncAttributeMaxDynamicSharedMemorySize, LDS_BYTES) != hipSuccess) { fprintf(stderr, "kernel_launch: hipFuncSetAttribute failed\n"); grid = -1; return; }
        if (hipOccupancyMaxActiveBlocksPerMultiprocessor(&per_cu, (const void*)mk_fwd, 512, LDS_BYTES) != hipSuccess || per_cu < 1)
            fprintf(stderr, "kernel_launch: occupancy query reports %d workgroups per CU\n", per_cu);
        (void)hipGetLastError();
        grid = cus;
    }
    if (grid < 0) return;
    if (hipMemsetAsync((char*)d_ws + WS_CTL, 0, CTL_ZERO_BYTES, stream) != hipSuccess) return;
    Args a{};
    for (int i = 0; i < 22; ++i) a.in[i] = (const float*)d_in[i];
    a.out = (float*)d_out; a.ws = (unsigned char*)d_ws;
#if MK_PER_PHASE
#ifndef PROBE_LAUNCH
#define PROBE_LAUNCH -1
#endif
    for (int p = 0; p < N_PHASES; ++p) { a.ph_lo = p; a.ph_hi = p + 1;
        for (int rep = 0; rep < (p == PROBE_LAUNCH ? 2 : 1); ++rep) {
            if (rep && p == 7) (void)hipMemsetAsync((char*)d_ws + WS_CTL + CW_GCNT * 4, 0, 256, stream);
            hipLaunchKernelGGL(mk_fwd, dim3(grid), dim3(512), LDS_BYTES, stream, a); } }
#else
    a.ph_lo = 0; a.ph_hi = N_PHASES; hipLaunchKernelGGL(mk_fwd, dim3(grid), dim3(512), LDS_BYTES, stream, a);
#endif
}
```

```cpp
#ifndef MK_DOC
#define MK_DOC 1
#endif
#include <hip/hip_runtime.h>
#include <cstdio>
#include <cstdint>

#define DI __device__ __forceinline__
#ifndef PROBE_BLOCK
#define PROBE_BLOCK 37
#endif
#ifndef PROBE_SCALE
#define PROBE_SCALE 1
#endif
#define LAS __attribute__((address_space(3)))
#define GAS __attribute__((address_space(1)))
typedef unsigned short bf16_t;
typedef short bf16x8 __attribute__((ext_vector_type(8)));
typedef float f32x4 __attribute__((ext_vector_type(4)));
typedef float f32x2 __attribute__((ext_vector_type(2)));
typedef unsigned u32x4 __attribute__((ext_vector_type(4)));
typedef unsigned u32x2 __attribute__((ext_vector_type(2)));

constexpr int T = 32768, DM = 1024, NBATCH = 4, SEQ = 8192, MEML = 256;
constexpr int NEXP = 64, DEXP = 512;
constexpr float ALPHA = 1.189207115002721f;
constexpr float LN_EPS = 1e-5f;
constexpr int LIST_CAP = 32768;

constexpr size_t MiB = 1u << 20;
constexpr size_t WS_CTL = 0, CTL_ZERO_BYTES = 64 * 1024;
constexpr size_t WS_W1T = 1 * MiB;
constexpr size_t WS_WKVT = 13 * MiB;
constexpr size_t WS_WFOT = 15 * MiB, WS_WNAT = 16 * MiB, WS_WMOT = 17 * MiB;
constexpr size_t WS_WOUTT = 18 * MiB;
constexpr size_t WS_WRT = 20 * MiB;
constexpr size_t WS_F64 = 20 * MiB + 256 * 1024;
constexpr size_t WS_C128 = 20 * MiB + 320 * 1024;
constexpr size_t WS_LIST = 21 * MiB;
constexpr size_t WS_REC = 29 * MiB;
constexpr size_t WS_R1 = 30 * MiB;
constexpr size_t WS_R2 = 94 * MiB;
constexpr size_t WS_R3 = 158 * MiB;
constexpr size_t WS_R4 = 222 * MiB;
constexpr size_t WS_R5 = 286 * MiB;
constexpr size_t WS_R6 = 350 * MiB;
constexpr size_t WS_KVM = 542 * MiB;
constexpr size_t WS_MEMB = 544 * MiB;
constexpr size_t WS_END = 546 * MiB;
constexpr size_t WS_XB = WS_R1, WS_T1 = WS_R1, WS_H = WS_R1;
constexpr size_t WS_ZT = WS_R2, WS_Y = WS_R4 + 32 * MiB;
constexpr size_t WS_Q = WS_R3, WS_K = WS_R3 + 32 * MiB, WS_MERGED = WS_R3;
constexpr size_t WS_VT = WS_R4, WS_QM = WS_R4 + 32 * MiB;
constexpr size_t WS_ONA = WS_R5, WS_OMEM = WS_R5 + 32 * MiB;
constexpr size_t WS_GATES = WS_R6, WS_WGUT = WS_R6, WS_WDT = WS_R6 + 128 * MiB;
constexpr size_t WS_V = WS_R4;
constexpr size_t WS_HMOE = 270 * MiB;
constexpr size_t WS_YB = 94 * MiB;
constexpr int CW_BAR = 4096;
constexpr int CW_GCNT = 8192, GCNT_PAD = 32;
constexpr int CW_KVDONE = 10496;

constexpr int RING_BYTES = 131072;
constexpr int MISC_OFF = RING_BYTES;
constexpr int LDS_BYTES = 147456;
constexpr int MS_BAR = 0, MS_TSTART = 64, MS_CNT = 512, MS_TILEE = 1024, MS_HIST = 2048, MS_BASE = 2560;

DI unsigned pk2(float lo, float hi) {
    typedef __bf16 bf2 __attribute__((ext_vector_type(2)));
    f32x2 v = {lo, hi};
    bf2 r = __builtin_convertvector(v, bf2);
    return __builtin_bit_cast(unsigned, r);
}
DI size_t blk_off(int r, int c, int ncols) { return ((size_t)(r >> 4) * (ncols >> 5) + (c >> 5)) * 512 + (r & 15) * 32 + (c & 31); }
DI float bf_lo(unsigned w) { return __uint_as_float(w << 16); }
DI float bf_hi(unsigned w) { return __uint_as_float(w & 0xffff0000u); }
DI float wave_sum(float v) {
#pragma unroll
    for (int o = 1; o < 64; o <<= 1) v += __shfl_xor(v, o);
    return v;
}
DI float fast_sigmoid(float z) { return __builtin_amdgcn_rcpf(1.0f + __builtin_amdgcn_exp2f(-1.4426950408889634f * z)); }
#define LDS_WAIT() asm volatile("s_waitcnt lgkmcnt(0)" ::: "memory")
#define VM_WAIT() asm volatile("s_waitcnt vmcnt(0)" ::: "memory")

#define XB_TMO      128
#define XB_XCNT(j)  (256  + 64 * (j))
#define XB_XSUB(j)  (1280 + 64 * (j))
#define XB_XGEN(j)  (2304 + 64 * (j))
#define XB_TOP      3328
#define XB_TOPGEN   3392
#define XCD_BAR_WORDS 3456
#define XB_SPIN_CAP (1u << 18)

__device__ __forceinline__ unsigned xb_ld(unsigned* p)              { return __hip_atomic_load(p, __ATOMIC_RELAXED, __HIP_MEMORY_SCOPE_AGENT); }
__device__ __forceinline__ unsigned xb_add(unsigned* p, unsigned v) { return __hip_atomic_fetch_add(p, v, __ATOMIC_RELAXED, __HIP_MEMORY_SCOPE_AGENT); }
__device__ __forceinline__ unsigned xb_xcc_id() { return (unsigned)__builtin_amdgcn_s_getreg((3 << 11) | 20) & 0xFu; }
#define XB_SPIN(cond, bar) do { unsigned _sp = 0; while (cond) { __builtin_amdgcn_s_sleep(1); \
    if ((++_sp & 255u) == 0u) { if (xb_ld(&(bar)[XB_TMO])) break; if (_sp > XB_SPIN_CAP) { atomicAdd(&(bar)[XB_TMO], 1u); break; } } } } while (0)

struct XcdBarrier {
    unsigned* bar; unsigned x;
    volatile LAS unsigned* st;
};
__device__ __forceinline__ XcdBarrier xcd_barrier_post(unsigned* bar, volatile LAS unsigned* st) {
    XcdBarrier b; b.bar = bar; b.x = xb_xcc_id(); b.st = st;
    if (threadIdx.x == 0) (void)xb_add(&bar[XB_XCNT(b.x)], 1u);
    return b;
}
__device__ __forceinline__ void xcd_barrier_complete(unsigned* bar, unsigned x, unsigned& nloc, unsigned& nx) {
    const unsigned G = gridDim.x * gridDim.y * gridDim.z;
    unsigned sum, cnt, mine, sp = 0u;
    for (;;) {
        sum = 0u; cnt = 0u; mine = 0u;
#pragma unroll
        for (unsigned j = 0; j < 16; ++j) { const unsigned c = xb_ld(&bar[XB_XCNT(j)]); sum += c; cnt += (c > 0u) ? 1u : 0u; mine = (j == x) ? c : mine; }
        if (sum == G) break;
        __builtin_amdgcn_s_sleep(1);
        if ((++sp & 255u) == 0u) { if (xb_ld(&bar[XB_TMO])) break; if (sp > XB_SPIN_CAP) { atomicAdd(&bar[XB_TMO], 1u); break; } }
    }
    nloc = mine > 0u ? mine : 1u; nx = cnt > 0u ? cnt : 1u;
}
__device__ __forceinline__ void xcd_barrier(const XcdBarrier& b) {
    asm volatile("s_waitcnt vmcnt(0)" ::: "memory");
    __syncthreads();
    if (threadIdx.x == 0) {
        unsigned* bar = b.bar;
        __builtin_amdgcn_s_waitcnt(0);
        unsigned nloc = b.st[0], nx = b.st[1];
        if (nloc == 0u) { xcd_barrier_complete(bar, b.x, nloc, nx); b.st[0] = nloc; b.st[1] = nx; }
        const unsigned old = xb_add(&bar[XB_XSUB(b.x)], 1u);
        const unsigned gen = old / nloc;
        if (old + 1u == (gen + 1u) * nloc) {
            __builtin_amdgcn_fence(__ATOMIC_RELEASE, "agent");
            asm volatile("s_waitcnt vmcnt(0)" ::: "memory");
            const unsigned og = xb_add(&bar[XB_TOP], 1u);
            const unsigned tg = og / nx;
            if (og + 1u == (tg + 1u) * nx) xb_add(&bar[XB_TOPGEN], 1u);
            else XB_SPIN(xb_ld(&bar[XB_TOPGEN]) == tg, bar);
            __builtin_amdgcn_fence(__ATOMIC_ACQUIRE, "agent");
            xb_add(&bar[XB_XGEN(b.x)], 1u);
            asm volatile("s_waitcnt vmcnt(0)" ::: "memory");
        } else {
            XB_SPIN(xb_ld(&bar[XB_XGEN(b.x)]) == gen, bar);
            __builtin_amdgcn_fence(__ATOMIC_ACQUIRE, "agent");
            asm volatile("s_waitcnt vmcnt(0)" ::: "memory");
        }
    }
    __syncthreads();
}

namespace pg8 {
constexpr int BM = 256, BK = 64, HALF = 128, HTB = HALF * BK * 2, STAGE_BYTES = 8 * HTB;
DI int swz_s(int q) { return (0x78 >> (2 * q)) & 3; }
DI int lds_byte(int r, int c) { const int st = (r >> 4) * 2 + (c >> 5), rr = r & 15, cc = c & 31, ob = rr * 64 + cc * 2; return st * 1024 + (ob ^ (swz_s((ob >> 8) & 3) << 4)); }
DI void stage_rc(int b, int& R, int& C) { const int st = b / 1024, sb = b % 1024, swz = sb ^ (swz_s((sb >> 8) & 3) << 4); R = (st >> 1) * 16 + swz / 64; C = (st & 1) * 32 + (swz % 64) / 2; }
DI int perm32(int rho) { const int n = rho >> 4, i = rho & 15; return 8 * (i >> 2) + 4 * n + (i & 3); }

struct GU { const char* A; const char* B; int p0, p1, p2, p3; };
typedef f32x4 Acc[2][2][4][2];

DI unsigned off_plain(int r, int c, int K) { return (unsigned)(r * K + c) * 2u; }
DI unsigned off_blk(int r, int c, int K) { return (unsigned)(((r >> 4) * (K >> 5) + (c >> 5)) * 1024 + (r & 15) * 64 + (c & 31) * 2); }
DI void tile_order(int L, int nM, int nN, int& pm, int& pn) {
    const int nwg = nM * nN; int wgid = L;
    { const int q = nwg / 8, r = nwg % 8, xcd = wgid % 8, off = wgid / 8; wgid = (xcd < r ? xcd * (q + 1) : r * (q + 1) + (xcd - r) * q) + off; }
    const int nig = 8 * nN, gid = wgid / nig, fm = gid * 8, gsz = (nM - fm) < 8 ? (nM - fm) : 8;
    pm = fm + ((wgid % nig) % gsz); pn = (wgid % nig) / gsz;
}

template <class Epi, class Sched>
DI void gemm_phase(LAS unsigned char* lds, const Sched& S, const Epi& E) {
    const int tid = threadIdx.x, wid = __builtin_amdgcn_readfirstlane(tid >> 6), lane = tid & 63, wr = wid >> 2, wc = wid & 3, fr = lane & 15, fq = lane >> 4;
    const int K = S.K, nt = K / BK;
    int Rs[2], Cs[2];
    unsigned voffB[2], vA[2][2], nA_[2][2];
#pragma unroll
    for (int i = 0; i < 2; ++i) { stage_rc(tid * 16 + i * 8192, Rs[i], Cs[i]); const int Rb = Epi::PERM ? ((Rs[i] & ~31) + perm32(Rs[i] & 31)) : Rs[i];
        voffB[i] = S.voffB(Rb, Cs[i]);
        vA[0][i] = S.voffA(Rs[i], Cs[i]); vA[1][i] = vA[0][i] + S.hstepA(); nA_[0][i] = vA[0][i]; nA_[1][i] = vA[1][i]; }
    const size_t kstepA = S.kstepA(), kstepB = S.kstepB();
    const size_t hstepB = S.hstepB();
    const unsigned ldsw = (unsigned)wid * 1024u;
    const int aoff = lds_byte(wr * 64 + fr, fq * 8), boff = lds_byte(wc * 32 + fr, fq * 8);
#define PG8_SA(b, h) (((b) * 2 + (h)) * HTB)
#define PG8_SB(b, h) ((4 + (b) * 2 + (h)) * HTB)
#define PG8_STAGE2(bufoff, gbase, v0, v1) do { \
        __builtin_amdgcn_global_load_lds((const unsigned*)((const char*)(gbase) + (v0)), (LAS unsigned*)(lds + (bufoff) + ldsw), 16, 0, 0); \
        __builtin_amdgcn_global_load_lds((const unsigned*)((const char*)(gbase) + (v1)), (LAS unsigned*)(lds + (bufoff) + ldsw + 8192), 16, 0, 0); } while (0)
#define PG8_STAGEB(bufoff, gbase) PG8_STAGE2(bufoff, gbase, voffB[0], voffB[1])
#define PG8_LDA(dst, b, h) do { _Pragma("unroll") for (int m = 0; m < 4; ++m) _Pragma("unroll") for (int k = 0; k < 2; ++k) dst[m][k] = *(const LAS bf16x8*)(lds + PG8_SA(b, h) + aoff + m * 2048 + k * 1024); } while (0)
#define PG8_LDB(dst, b, h) do { _Pragma("unroll") for (int n = 0; n < 2; ++n) _Pragma("unroll") for (int k = 0; k < 2; ++k) dst[n][k] = *(const LAS bf16x8*)(lds + PG8_SB(b, h) + boff + n * 2048 + k * 1024); } while (0)
#define PG8_MMA(ai, bj, At, Bt) do { __builtin_amdgcn_s_setprio(1); _Pragma("unroll") for (int m = 0; m < 4; ++m) _Pragma("unroll") for (int n = 0; n < 2; ++n) _Pragma("unroll") for (int k = 0; k < 2; ++k) \
        acc[ai][bj][m][n] = __builtin_amdgcn_mfma_f32_16x16x32_bf16(Bt[n][k], At[m][k], acc[ai][bj][m][n], 0, 0, 0); __builtin_amdgcn_s_setprio(0); } while (0)
#define PG8_WAIT_V(n) asm volatile("s_waitcnt vmcnt(" #n ")" ::: "memory")
#define PG8_WAIT_L(n) asm volatile("s_waitcnt lgkmcnt(" #n ")" ::: "memory")
#define PG8_WAIT_VR(ns) asm volatile("s_cmp_lt_u32 %0, 8\n\ts_cbranch_scc1 .Lw8_%=\n\ts_cmp_lt_u32 %0, 16\n\ts_cbranch_scc1 .Lw16_%=\n\ts_cmp_lt_u32 %0, 32\n\ts_cbranch_scc1 .Lw24_%=\n\t" \
        "s_waitcnt vmcnt(40)\n\ts_branch .Lwd_%=\n.Lw24_%=:\n\ts_waitcnt vmcnt(24)\n\ts_branch .Lwd_%=\n.Lw16_%=:\n\ts_waitcnt vmcnt(16)\n\ts_branch .Lwd_%=\n.Lw8_%=:\n\ts_waitcnt vmcnt(8)\n.Lwd_%=:" :: "s"(ns) : "memory", "scc")
#define PG8_BAR __builtin_amdgcn_s_barrier()
#define PG8_SCHED __builtin_amdgcn_sched_barrier(0)
    GU cur, nxt; int ui = 0, ns_prev = 0;
    if (!S.next(0, cur)) return;
#ifdef PROBE_SEL
    unsigned long long pk_ = 0, pe_ = 0, pt0_ = __builtin_amdgcn_s_memrealtime(), pa_ = 0, pb_ = 0;
#define PSTAMP(x) do { if (Sched::PROBE) x = __builtin_amdgcn_s_memrealtime(); } while (0)
#else
#define PSTAMP(x) do { } while (0)
#endif
    Acc acc;
#pragma unroll
    for (int a = 0; a < 2; ++a)
#pragma unroll
        for (int b = 0; b < 2; ++b)
#pragma unroll
            for (int m = 0; m < 4; ++m)
#pragma unroll
                for (int n = 0; n < 2; ++n) acc[a][b][m][n] = (f32x4){0.f, 0.f, 0.f, 0.f};
    bf16x8 At[4][2], B0[2][2], B1[2][2];
    const char* cA = cur.A; const char* cB = cur.B;
    if constexpr (Sched::GATHER) {
#pragma unroll
        for (int i = 0; i < 2; ++i) { vA[0][i] = S.gatherA(cur, Rs[i], Cs[i]); vA[1][i] = S.gatherA(cur, Rs[i] + 128, Cs[i]); }
    }
    PG8_STAGEB(PG8_SB(0, 0), cB); PG8_STAGEB(PG8_SB(0, 1), cB + hstepB); PG8_STAGE2(PG8_SA(0, 0), cA, vA[0][0], vA[0][1]); PG8_STAGE2(PG8_SA(0, 1), cA, vA[1][0], vA[1][1]);
    if (wr == 1) PG8_BAR;
    PG8_WAIT_V(2); PG8_BAR;
    PG8_STAGEB(PG8_SB(1, 0), cB + kstepB); PG8_STAGE2(PG8_SA(1, 0), cA + kstepA, vA[0][0], vA[0][1]); PG8_STAGEB(PG8_SB(1, 1), cB + hstepB + kstepB);
    PG8_WAIT_V(6); PG8_BAR;
    for (;;) {
        const bool has_next = S.next(ui + 1, nxt);
        const char* nA = has_next ? nxt.A : cA; const char* nB = has_next ? nxt.B : cB;
        if constexpr (Sched::GATHER) {
            if (has_next) {
#pragma unroll
                for (int i = 0; i < 2; ++i) { nA_[0][i] = S.gatherA(nxt, Rs[i], Cs[i]); nA_[1][i] = S.gatherA(nxt, Rs[i] + 128, Cs[i]); }
            } else {
#pragma unroll
                for (int i = 0; i < 2; ++i) { nA_[0][i] = vA[0][i]; nA_[1][i] = vA[1][i]; }
            }
        }
#ifdef PROBE_SEL
        PSTAMP(pa_);
#endif
        for (int t = 0; t < nt; t += 2) {
            const bool last = (t == nt - 2);
            const char* a1 = cA + (size_t)(t + 1) * kstepA;
            const char* a2 = last ? nA : cA + (size_t)(t + 2) * kstepA; const char* b2 = last ? nB : cB + (size_t)(t + 2) * kstepB;
            const char* a3 = a2 + kstepA; const char* b3 = b2 + kstepB;
            unsigned x00 = vA[0][0], x01 = vA[0][1], x10 = vA[1][0], x11 = vA[1][1];
            if constexpr (Sched::GATHER) { if (last) { x00 = nA_[0][0]; x01 = nA_[0][1]; x10 = nA_[1][0]; x11 = nA_[1][1]; } }
            const int nsr = ns_prev; ns_prev = 0; asm volatile("" : "+s"(ns_prev));
            PG8_LDB(B0, 0, 0); PG8_LDB(B1, 0, 1); PG8_SCHED; PG8_LDA(At, 0, 0); PG8_STAGE2(PG8_SA(1, 1), a1, vA[1][0], vA[1][1]);
            PG8_WAIT_VR(nsr); PG8_WAIT_L(0); PG8_BAR; PG8_MMA(0, 0, At, B0); PG8_MMA(0, 1, At, B1); PG8_BAR; PG8_SCHED;
            PG8_LDA(At, 0, 1); PG8_STAGEB(PG8_SB(0, 0), b2); PG8_STAGEB(PG8_SB(0, 1), b2 + hstepB); PG8_STAGE2(PG8_SA(0, 0), a2, x00, x01);
            PG8_WAIT_VR(nsr); PG8_WAIT_L(0); PG8_BAR; PG8_MMA(1, 0, At, B0); PG8_MMA(1, 1, At, B1); PG8_BAR; PG8_SCHED;
            PG8_LDB(B0, 1, 0); PG8_LDB(B1, 1, 1); PG8_SCHED; PG8_LDA(At, 1, 0); PG8_STAGE2(PG8_SA(0, 1), a2, x10, x11);
            PG8_WAIT_V(8); PG8_WAIT_L(0); PG8_BAR; PG8_MMA(0, 0, At, B0); PG8_MMA(0, 1, At, B1); PG8_BAR; PG8_SCHED;
            PG8_LDA(At, 1, 1); PG8_STAGEB(PG8_SB(1, 0), b3); PG8_STAGEB(PG8_SB(1, 1), b3 + hstepB); PG8_STAGE2(PG8_SA(1, 0), a3, x00, x01);
            PG8_WAIT_V(8); PG8_WAIT_L(0); PG8_BAR; PG8_MMA(1, 0, At, B0); PG8_MMA(1, 1, At, B1); PG8_BAR; PG8_SCHED;
        }
#ifdef PROBE_SEL
        PSTAMP(pb_); pk_ += pb_ - pa_;
#endif
        if (wr == 0) PG8_BAR;
        E(acc, cur, wr, wc, fr, fq); ns_prev = E.nstores(cur);
#ifdef PROBE_SEL
        PSTAMP(pa_); pe_ += pa_ - pb_;
#endif
        if (!has_next) break;
        cur = nxt; cA = nA; cB = nB; ++ui;
        if constexpr (Sched::GATHER) {
#pragma unroll
            for (int i = 0; i < 2; ++i) { vA[0][i] = nA_[0][i]; vA[1][i] = nA_[1][i]; }
        }
        if (wr == 1) PG8_BAR;
    }
    PG8_WAIT_V(0);
    PG8_BAR;
#ifdef PROBE_SEL
    if (Sched::PROBE && blockIdx.x == PROBE_BLOCK && tid == 0) { const unsigned long long tot = __builtin_amdgcn_s_memrealtime() - pt0_;
        LAS unsigned long long* pr = (LAS unsigned long long*)(lds + MISC_OFF + 3072);
        pr[0] += (PROBE_SEL == 0 ? pk_ : (PROBE_SEL == 1 ? pe_ : (PROBE_SEL == 2 ? tot - pk_ - pe_ : tot))); }
#endif
#undef PSTAMP
#undef PG8_SA
#undef PG8_SB
#undef PG8_STAGE2
#undef PG8_STAGEB
#undef PG8_LDA
#undef PG8_LDB
#undef PG8_MMA
#undef PG8_WAIT_V
#undef PG8_WAIT_L
#undef PG8_WAIT_VR
#undef PG8_BAR
#undef PG8_SCHED
}
}
using pg8::GU; using pg8::Acc;

struct Args { const float* in[22]; float* out; unsigned char* ws; int ph_lo, ph_hi; };
struct Frame {
    LAS unsigned char* lds;
    int tid, lane, wave, G, vcu;
    unsigned char* ws;
};
enum { IN_X = 0, IN_MEM, IN_WIN, IN_WGATE, IN_BGATE, IN_WMEMKV, IN_RPB, IN_WFO, IN_WNAO, IN_WMEMO, IN_WOUT, IN_LN1G, IN_LN1B,
       IN_WRG, IN_BRG, IN_WRE, IN_BRE, IN_WEG, IN_WEU, IN_WED, IN_LN2G, IN_LN2B };

DI void cvt_row_1024(const float* src, bf16_t* dst, int lane) {
#pragma unroll
    for (int j = 0; j < 2; ++j) {
        const f32x4 a = *(const f32x4*)(src + j * 512 + lane * 8), b = *(const f32x4*)(src + j * 512 + lane * 8 + 4);
        u32x4 o; o.x = pk2(a.x, a.y); o.y = pk2(a.z, a.w); o.z = pk2(b.x, b.y); o.w = pk2(b.z, b.w);
        *(u32x4*)(dst + j * 512 + lane * 8) = o;
    }
}
DI void tr_tile(const float* W, int ldw, int colbase, int k0, bf16_t* WT, int ldt, int drow0, LAS float* scr, int lane, float sc = 1.0f) {
    float tv[32];
#pragma unroll
    for (int i = 0; i < 32; ++i) tv[i] = __builtin_nontemporal_load(W + (size_t)(k0 + 2 * i + (lane >> 5)) * ldw + colbase + (lane & 31));
#pragma unroll
    for (int i = 0; i < 32; ++i) scr[(2 * i + (lane >> 5)) * 33 + (lane & 31)] = tv[i] * sc;
    LDS_WAIT(); asm volatile("" ::: "memory");
    const int c = lane & 7;
#pragma unroll
    for (int j = 0; j < 4; ++j) { const int n = (lane >> 3) + 8 * j; const LAS float* s = scr + (8 * c) * 33 + n;
        u32x4 o; o.x = pk2(s[0 * 33], s[1 * 33]); o.y = pk2(s[2 * 33], s[3 * 33]); o.z = pk2(s[4 * 33], s[5 * 33]); o.w = pk2(s[6 * 33], s[7 * 33]);
        *(u32x4*)(WT + (size_t)(drow0 + n) * ldt + k0 + 8 * c) = o; }
    LDS_WAIT(); asm volatile("" ::: "memory");
}
DI void tr_item(const float* W, int ldw, int col0, int ncols, bf16_t* WT, int K, int row_off, LAS float* scr, int item, int lane, bool win = false) {
    const int nblk = ncols / 32, kb = item / nblk, nb = item % nblk;
    const int col = col0 + 32 * nb; const float sc = !win ? 1.0f : (col < 1024 ? 0.125f * 1.4426950408889634f : (col >= 2048 ? 0.08838834764831845f * 1.4426950408889634f : 1.0f));
    tr_tile(W, ldw, col, 64 * kb, WT, K, row_off + 32 * nb, scr, lane, sc);
}
DI void fold_item(const float* w_in, bf16_t* W1t, LAS float* scr, int item, int lane) {
    const int g = item >> 8, k0 = (item & 255) * 4, cp = lane;
    LAS float* wt = scr;
    LAS float* tc = scr + 512;
    LAS float* ts = scr + 640;
#pragma unroll
    for (int j = 0; j < 2; ++j) { const int idx = lane + 64 * j, kk = idx >> 5, c4 = idx & 31;
        const f32x4 v = *(const f32x4*)(w_in + (size_t)(k0 + kk) * 2560 + g * 128 + 4 * c4);
        *(LAS f32x4*)(wt + kk * 128 + 4 * c4) = v; }
#pragma unroll
    for (int j = 0; j < 2; ++j) { const int i = lane + 64 * j; float sv, cv; sincospif((float)i * (1.0f / 64.0f), &sv, &cv); tc[i] = cv; ts[i] = sv; }
    LDS_WAIT(); asm volatile("" ::: "memory");
    float re[4], im[4], alt[4];
#pragma unroll
    for (int kk = 0; kk < 4; ++kk) { re[kk] = 0.f; im[kk] = 0.f; alt[kk] = 0.f; }
    for (int c8 = 0; c8 < 128; c8 += 8) {
        float cs[8], sn[8]; f32x4 wv[4][2];
#pragma unroll
        for (int j = 0; j < 8; ++j) { const int idx = ((c8 + j) * cp) & 127; cs[j] = tc[idx]; sn[j] = ts[idx]; }
#pragma unroll
        for (int kk = 0; kk < 4; ++kk) { wv[kk][0] = *(const LAS f32x4*)(wt + kk * 128 + c8); wv[kk][1] = *(const LAS f32x4*)(wt + kk * 128 + c8 + 4); }
#pragma unroll
        for (int j = 0; j < 8; ++j)
#pragma unroll
            for (int kk = 0; kk < 4; ++kk) { const float w = wv[kk][j >> 2][j & 3]; re[kk] += w * cs[j]; im[kk] -= w * sn[j]; alt[kk] += (j & 1) ? -w : w; }
    }
    if (cp == 0) {
#pragma unroll
        for (int kk = 0; kk < 4; ++kk) im[kk] = alt[kk];
    }
    const float sc = 0.08838834764831845f;
    u32x2 o;
    o.x = pk2(re[0] * sc, re[1] * sc); o.y = pk2(re[2] * sc, re[3] * sc);
    *(u32x2*)(W1t + (size_t)(g * 128 + cp) * 1024 + k0) = o;
    o.x = pk2(im[0] * sc, im[1] * sc); o.y = pk2(im[2] * sc, im[3] * sc);
    *(u32x2*)(W1t + (size_t)(g * 128 + 64 + cp) * 1024 + k0) = o;
    LDS_WAIT(); asm volatile("" ::: "memory");
}
DI void p0_prologue(const Frame& F, const Args& a) {
    LAS float* scr = (LAS float*)(F.lds + F.wave * 16384);
    const int gw = F.vcu * 8 + F.wave, NGW = F.G * 8, lane = F.lane;
    unsigned char* ws = F.ws;
    bf16_t* W1t = (bf16_t*)(ws + WS_W1T);
#pragma unroll 1
    for (int ps = 0; ps < 2; ++ps) {
    if ((ps ^ (F.wave & 1)) == 0) {
    constexpr int I_IN = 16 * 64, I_GATE = 16 * 96, I_KV = 16 * 32, I_BR = 8 * 32, I_OUT = 16 * 32, I_FOLD = 1024;
    constexpr int NITEMS = I_FOLD + I_IN + I_GATE + I_KV + 3 * I_BR + I_OUT;
    for (int it = gw; it < NITEMS; it += NGW) {
        int r = it;
        if (r < I_FOLD) { fold_item(a.in[IN_WIN], W1t, scr, r, lane); continue; } r -= I_FOLD;
        if (r < I_IN) { tr_item(a.in[IN_WIN], 2560, 512, 2048, W1t, 1024, 1024, scr, r, lane, true); continue; } r -= I_IN;
        if (r < I_GATE) { tr_item(a.in[IN_WGATE], 3072, 0, 3072, W1t, 1024, 3072, scr, r, lane); continue; } r -= I_GATE;
        if (r < I_KV) { tr_item(a.in[IN_WMEMKV], 1024, 0, 1024, (bf16_t*)(ws + WS_WKVT), 1024, 0, scr, r, lane); continue; } r -= I_KV;
        if (r < I_BR) { tr_item(a.in[IN_WFO], 1024, 0, 1024, (bf16_t*)(ws + WS_WFOT), 512, 0, scr, r, lane); continue; } r -= I_BR;
        if (r < I_BR) { tr_item(a.in[IN_WNAO], 1024, 0, 1024, (bf16_t*)(ws + WS_WNAT), 512, 0, scr, r, lane); continue; } r -= I_BR;
        if (r < I_BR) { tr_item(a.in[IN_WMEMO], 1024, 0, 1024, (bf16_t*)(ws + WS_WMOT), 512, 0, scr, r, lane); continue; } r -= I_BR;
        tr_item(a.in[IN_WOUT], 1024, 0, 1024, (bf16_t*)(ws + WS_WOUTT), 1024, 0, scr, r, lane);
    }
    } else {
    for (int m = gw; m < T; m += 2 * NGW) {
        const float* s0 = a.in[IN_X] + (size_t)m * DM; const int m1 = m + NGW < T ? m + NGW : m; const float* s1 = a.in[IN_X] + (size_t)m1 * DM;
        f32x4 va[4], vb[4];
#pragma unroll
        for (int j = 0; j < 2; ++j) { va[2 * j] = __builtin_nontemporal_load((const f32x4*)(s0 + j * 512 + lane * 8)); va[2 * j + 1] = __builtin_nontemporal_load((const f32x4*)(s0 + j * 512 + lane * 8 + 4));
                                      vb[2 * j] = __builtin_nontemporal_load((const f32x4*)(s1 + j * 512 + lane * 8)); vb[2 * j + 1] = __builtin_nontemporal_load((const f32x4*)(s1 + j * 512 + lane * 8 + 4)); }
        bf16_t* d0 = (bf16_t*)(ws + WS_XB) + (size_t)m * DM; bf16_t* d1 = (bf16_t*)(ws + WS_XB) + (size_t)m1 * DM;
#pragma unroll
        for (int j = 0; j < 2; ++j) { u32x4 o; o.x = pk2(va[2 * j].x, va[2 * j].y); o.y = pk2(va[2 * j].z, va[2 * j].w); o.z = pk2(va[2 * j + 1].x, va[2 * j + 1].y); o.w = pk2(va[2 * j + 1].z, va[2 * j + 1].w);
            *(u32x4*)(d0 + j * 512 + lane * 8) = o;
            o.x = pk2(vb[2 * j].x, vb[2 * j].y); o.y = pk2(vb[2 * j].z, vb[2 * j].w); o.z = pk2(vb[2 * j + 1].x, vb[2 * j + 1].y); o.w = pk2(vb[2 * j + 1].z, vb[2 * j + 1].w);
            *(u32x4*)(d1 + j * 512 + lane * 8) = o; }
    }
    for (int m = gw; m < NBATCH * MEML; m += NGW) cvt_row_1024(a.in[IN_MEM] + (size_t)m * DM, (bf16_t*)(ws + WS_MEMB) + (size_t)m * DM, lane);
    }
    }
    const int gt = F.vcu * 512 + F.tid, NGT = F.G * 512;
    { bf16_t* wr = (bf16_t*)(ws + WS_WRT);
      for (int i = gt; i < 80 * 1024; i += NGT) { const int r = i >> 10, k = i & 1023;
          const float v = r < 64 ? a.in[IN_WRE][k * 64 + r] : (r < 72 ? a.in[IN_WRG][k * 8 + (r - 64)] : 0.f);
          wr[i] = (bf16_t)(pk2(v, 0.f) & 0xffffu); } }
    { bf16_t* f = (bf16_t*)(ws + WS_F64);
      for (int i = gt; i < 128 * 128; i += NGT) { const int j = i & 7, ln = (i >> 3) & 63, nt = (i >> 9) & 7, ks = i >> 12;
          const int k = 32 * ks + 8 * (ln >> 4) + j, m = 16 * nt + (ln & 15), ri = k >> 6, n1 = k & 63, rip = m >> 6, k1 = m & 63;
          float sv, cv; sincospif((float)((n1 * k1) & 63) * (1.0f / 32.0f), &sv, &cv);
          const float v = (ri == rip) ? cv : (ri == 1 ? sv : -sv);
          f[i] = (bf16_t)(pk2(v * 0.125f, 0.f) & 0xffffu); } }
    { bf16_t* f = (bf16_t*)(ws + WS_C128);
      for (int i = gt; i < 256 * 128; i += NGT) { const int j = i & 7, ln = (i >> 3) & 63, nt = (i >> 9) & 7, ks = i >> 12;
          const int k = 32 * ks + 8 * (ln >> 4) + j, k2 = 16 * nt + (ln & 15), rip = k >> 7, n2 = k & 127;
          float sv, cv; sincospif((float)((n2 * k2) & 127) * (1.0f / 64.0f), &sv, &cv);
          f[i] = (bf16_t)(pk2((rip == 0 ? cv : sv) * 0.08838834764831845f, 0.f) & 0xffffu); } }
}
struct TrDesc { const float* src; bf16_t* dst; int ldw, ldt; int nt; float sc; };
DI void tr_load(f32x4 (&tv)[8], const TrDesc& d, int lane) {
#pragma unroll
    for (int i = 0; i < 8; ++i) tv[i] = __builtin_nontemporal_load((const f32x4*)(d.src + (size_t)(8 * i + (lane >> 3)) * d.ldw + 4 * (lane & 7)));
}
DI void tr_store(const f32x4 (&tv)[8], const TrDesc& d, LAS float* scr, int lane) {
#pragma unroll
    for (int i = 0; i < 8; ++i) { LAS float* q = scr + (8 * i + (lane >> 3)) * 33 + 4 * (lane & 7); const f32x4 t = tv[i] * d.sc; q[0] = t[0]; q[1] = t[1]; q[2] = t[2]; q[3] = t[3]; }
    LDS_WAIT(); asm volatile("" ::: "memory");
    const int c = lane & 7;
#pragma unroll
    for (int j = 0; j < 4; ++j) { const int n = (lane >> 3) + 8 * j; const LAS float* p = scr + (8 * c) * 33 + n;
        u32x4 o; o.x = pk2(p[0 * 33], p[1 * 33]); o.y = pk2(p[2 * 33], p[3 * 33]); o.z = pk2(p[4 * 33], p[5 * 33]); o.w = pk2(p[6 * 33], p[7 * 33]);
        if (d.nt) __builtin_nontemporal_store(o, (u32x4*)(d.dst + (size_t)n * d.ldt + 8 * c)); else *(u32x4*)(d.dst + (size_t)n * d.ldt + 8 * c) = o; }
    LDS_WAIT(); asm volatile("" ::: "memory");
}
template <class Dec> DI void tr_run(const Dec& dec, int first, int n, int stride, LAS float* scr, int lane) {
    if (first >= n) return;
    f32x4 ta[8], tb[8], tc[8];
    TrDesc d0 = dec(first), d1 = dec(min(first + stride, n - 1)), d2 = d1;
    tr_load(ta, d0, lane); tr_load(tb, d1, lane);
    for (int it = first; ; it += 3 * stride) {
        d2 = dec(min(it + 2 * stride, n - 1)); tr_load(tc, d2, lane);
        tr_store(ta, d0, scr, lane);
        if (it + stride >= n) break;
        d0 = dec(min(it + 3 * stride, n - 1)); tr_load(ta, d0, lane);
        tr_store(tb, d1, scr, lane);
        if (it + 2 * stride >= n) break;
        d1 = dec(min(it + 4 * stride, n - 1)); tr_load(tb, d1, lane);
        tr_store(tc, d2, scr, lane);
        if (it + 3 * stride >= n) break;
    }
}
struct DecGU { const float* weg; const float* weu; bf16_t* wgu;
    DI TrDesc operator()(int it) const { const int e = it >> 9; int r = it & 511; const int up = r >> 8; r &= 255; const int kb = r >> 4, nb = r & 15, n0 = 32 * nb;
        const float* wsel = (const float*)((size_t)weg + (size_t)up * ((size_t)weu - (size_t)weg));
        TrDesc d; d.src = wsel + (size_t)e * 1024 * 512 + (size_t)(64 * kb) * 512 + n0; d.ldw = 512;
        d.dst = wgu + (size_t)e * 1024 * 1024 + (size_t)((n0 >> 7) * 256 + up * 128 + (n0 & 127)) * 1024 + 64 * kb; d.ldt = 1024; d.nt = 1; d.sc = up ? -0.6931471805599453f : -1.4426950408889634f; return d; } };
struct DecDown { const float* wed; bf16_t* wd;
    DI TrDesc operator()(int it) const { const int e = it >> 8, r = it & 255, kb = r >> 5, nb = r & 31;
        TrDesc d; d.src = wed + (size_t)e * 512 * 1024 + (size_t)(64 * kb) * 1024 + 32 * nb; d.ldw = 1024;
        d.dst = wd + (size_t)e * 1024 * 512 + (size_t)(32 * nb) * 512 + 64 * kb; d.ldt = 512; d.nt = 0; d.sc = 1.0f; return d; } };
#ifndef CVT_A_TILES
#define CVT_A_TILES 13312
#endif
DI void p_expert_cvt_gu(const Frame& F, const Args& a, bool first_group) {
    DecGU dec{a.in[IN_WEG], a.in[IN_WEU], (bf16_t*)(F.ws + WS_WGUT)};
    int lane = F.lane; asm volatile("" : "+v"(lane));
    if (F.G % 2 == 0) { const int lo = first_group ? 0 : CVT_A_TILES, hi = first_group ? CVT_A_TILES : NEXP * 512;
        tr_run(dec, lo + (F.vcu >> 1) * 8 + F.wave, hi, (F.G >> 1) * 8, (LAS float*)(F.lds + F.wave * 16384), lane); }
    else tr_run(dec, F.vcu * 8 + F.wave, NEXP * 512, F.G * 8, (LAS float*)(F.lds + F.wave * 16384), lane);
}
DI void p_expert_cvt_down(const Frame& F, const Args& a, int part, int nparts, int lo, int hi) {
    DecDown dec{a.in[IN_WED], (bf16_t*)(F.ws + WS_WDT)};
    int lane = F.lane; asm volatile("" : "+v"(lane));
    tr_run(dec, lo + part * 8 + F.wave, hi, nparts * 8, (LAS float*)(F.lds + F.wave * 16384), lane);
}

template <bool BIAS> struct EpiP1 {
    static constexpr bool PERM = true;
    DI int nstores(const GU&) const { return 16; }
    unsigned char* ws; const float* bgate;
    DI void operator()(Acc& acc, const GU& u, int wr, int wc, int fr, int fq) const {
        bf16_t* base; int ncols;
        if constexpr (BIAS) { base = (bf16_t*)(ws + WS_GATES); ncols = 3072; }
        else switch (u.p0) {
            case 0: base = (bf16_t*)(ws + WS_ZT); ncols = 8192; break;
            case 1: base = (bf16_t*)(ws + WS_Q); ncols = 512; break;
            case 2: base = (bf16_t*)(ws + WS_K); ncols = 512; break;
            case 3: base = (bf16_t*)(ws + WS_VT); ncols = 8192; break;
            case 4: base = (bf16_t*)(ws + WS_QM); ncols = 512; break;
            case 6: base = (bf16_t*)(ws + WS_KVM); ncols = 512; break;
            default: base = (bf16_t*)(ws + WS_KVM + MiB); ncols = 256; break;
        }
        const int row0 = u.p1 * 256 + wr * 64 + fr, col0 = u.p2 * 256 + wc * 32 + 8 * fq;
        f32x4 bv[2][2];
        if constexpr (BIAS) {
            const float* bias = bgate + col0;
#pragma unroll
            for (int bj = 0; bj < 2; ++bj)
#pragma unroll
                for (int n = 0; n < 2; ++n) bv[bj][n] = *(const f32x4*)(bias + bj * 128 + 4 * n) * (-1.4426950408889634f);
        }
#pragma unroll
        for (int ai = 0; ai < 2; ++ai)
#pragma unroll
            for (int m = 0; m < 4; ++m) {
#pragma unroll
                for (int bj = 0; bj < 2; ++bj) { f32x4 v0 = acc[ai][bj][m][0], v1 = acc[ai][bj][m][1];
                    if constexpr (BIAS) {
                        v0 = v0 * (-1.4426950408889634f) + bv[bj][0]; v1 = v1 * (-1.4426950408889634f) + bv[bj][1];
#pragma unroll
                        for (int j = 0; j < 4; ++j) { v0[j] = fminf(__builtin_amdgcn_exp2f(v0[j]) + 1.0f, 1048576.0f); v1[j] = fminf(__builtin_amdgcn_exp2f(v1[j]) + 1.0f, 1048576.0f); }
                    }
                    u32x4 w; w.x = pk2(v0[0], v0[1]); w.y = pk2(v0[2], v0[3]); w.z = pk2(v1[0], v1[1]); w.w = pk2(v1[2], v1[3]);
                    if constexpr (BIAS) __builtin_nontemporal_store(w, (u32x4*)(base + blk_off(row0 + ai * 128 + m * 16, col0 + bj * 128, ncols)));
                    else *(u32x4*)(base + blk_off(row0 + ai * 128 + m * 16, col0 + bj * 128, ncols)) = w;
                    acc[ai][bj][m][0] = (f32x4){0.f, 0.f, 0.f, 0.f}; acc[ai][bj][m][1] = (f32x4){0.f, 0.f, 0.f, 0.f}; } }
    }
};
struct SchedP1F {
    static constexpr bool GATHER = false; static constexpr bool PROBE = false;
    int K, G, c; const char* xb; const char* w1t;
    DI unsigned voffA(int r, int c) const { return pg8::off_plain(r, c, 1024); }
    DI unsigned hstepA() const { return 128u * 2048u; }
    DI unsigned kstepA() const { return 128u; }
    DI unsigned voffB(int r, int c) const { return pg8::off_plain((r & 63) * 128 + (r >> 6), c, 1024); }
    DI unsigned hstepB() const { return 2u * 2048u; }
    DI unsigned kstepB() const { return 128u; }
    DI unsigned gatherA(const GU&, int, int) const { return 0u; }
    DI bool next(int i, GU& u) const {
        const int L = i * G + c; if (L >= 256) return false;
        int pm, pn; pg8::tile_order(L, 128, 2, pm, pn);
        const int b = pm >> 5, pp = pm & 31;
        u.A = w1t + (size_t)pn * 256 * 2048; u.B = xb + ((size_t)b * 8192 + 4 * pp) * 2048;
        u.p0 = 0; u.p1 = b * 2 + pn; u.p2 = pp; u.p3 = 0; return true;
    }
};
struct SchedP1a {
    static constexpr bool GATHER = false; static constexpr bool PROBE = false;
    int K, G, c; const char* xb; const char* w1t; const char* memb; const char* wkvt;
    DI unsigned voffA(int r, int c) const { return pg8::off_plain(r, c, 1024); }
    DI unsigned hstepA() const { return 128u * 2048u; }
    DI unsigned kstepA() const { return 128u; }
    DI unsigned voffB(int r, int c) const { return pg8::off_plain(r, c, 1024); }
    DI unsigned hstepB() const { return 128u * 2048u; }
    DI unsigned kstepB() const { return 128u; }
    DI unsigned gatherA(const GU&, int, int) const { return 0u; }
    DI bool next(int i, GU& u) const {
        const int L = i * G + c; u.p3 = 0;
        if (L < 1024) {
            int pm, pn; pg8::tile_order(L, 128, 8, pm, pn);
            const char* xt = xb + (size_t)pm * 256 * 2048;
            if (pn < 2)       { u.A = xt; u.B = w1t + (size_t)(1024 + 256 * pn) * 2048; u.p0 = 1; u.p1 = pm; u.p2 = pn; }
            else if (pn < 4)  { u.A = xt; u.B = w1t + (size_t)(1536 + 256 * (pn - 2)) * 2048; u.p0 = 2; u.p1 = pm; u.p2 = pn - 2; }
            else if (pn < 6)  { u.A = w1t + (size_t)(2048 + 256 * (pn - 4)) * 2048; u.B = xt; u.p0 = 3; u.p1 = (pm >> 5) * 2 + (pn - 4); u.p2 = pm & 31; }
            else              { u.A = xt; u.B = w1t + (size_t)(2560 + 256 * (pn - 6)) * 2048; u.p0 = 4; u.p1 = pm; u.p2 = pn - 6; }
            return true;
        }
        return false;
    }
};
struct SchedKV {
    static constexpr bool GATHER = false; static constexpr bool PROBE = false;
    int K, j; const char* memb; const char* wkvt;
    DI unsigned voffA(int r, int c) const { return pg8::off_plain(r, c, 1024); }
    DI unsigned hstepA() const { return 128u * 2048u; }
    DI unsigned kstepA() const { return 128u; }
    DI unsigned voffB(int r, int c) const { return pg8::off_plain(r, c, 1024); }
    DI unsigned hstepB() const { return 128u * 2048u; }
    DI unsigned kstepB() const { return 128u; }
    DI unsigned gatherA(const GU&, int, int) const { return 0u; }
    DI bool next(int i, GU& u) const {
        if (i > 0 || j < 0) return false; u.p3 = 0;
        if (j < 8) { const int pm = j >> 1, pn = j & 1; u.A = memb + (size_t)pm * 256 * 2048; u.B = wkvt + (size_t)pn * 256 * 2048; u.p0 = 6; u.p1 = pm; u.p2 = pn; }
        else { const int f = (j - 8) >> 2, b = (j - 8) & 3; u.A = wkvt + (size_t)(512 + 256 * f) * 2048; u.B = memb + (size_t)b * 256 * 2048; u.p0 = 7; u.p1 = b * 2 + f; u.p2 = 0; }
        return true;
    }
};
struct SchedP1g {
    static constexpr bool GATHER = false; static constexpr bool PROBE = false;
    int K, G, c; const char* xb; const char* w1t;
    DI unsigned voffA(int r, int c) const { return pg8::off_plain(r, c, 1024); }
    DI unsigned hstepA() const { return 128u * 2048u; }
    DI unsigned kstepA() const { return 128u; }
    DI unsigned voffB(int r, int c) const { return pg8::off_plain(r, c, 1024); }
    DI unsigned hstepB() const { return 128u * 2048u; }
    DI unsigned kstepB() const { return 128u; }
    DI unsigned gatherA(const GU&, int, int) const { return 0u; }
    DI bool next(int i, GU& u) const {
        const int L = i * G + c; if (L >= 1536) return false;
        int pm, pn; pg8::tile_order(L, 128, 12, pm, pn);
        u.A = xb + (size_t)pm * 256 * 2048; u.B = w1t + (size_t)(3072 + 256 * pn) * 2048; u.p0 = 5; u.p1 = pm; u.p2 = pn; u.p3 = 0; return true;
    }
};

struct EpiMerge {
    static constexpr bool PERM = true;
    DI int nstores(const GU& u) const { return u.p0 == 2 ? 16 : 0; }
    const bf16_t* gates; bf16_t* merged;
    DI void operator()(Acc& acc, const GU& u, int wr, int wc, int fr, int fq) const {
        const int seg = u.p0, pm = u.p1, pn = u.p2;
        const int row0 = pm * 256 + wr * 64 + fr, col0 = pn * 256 + wc * 32 + 8 * fq;
        const int nxt_off = seg < 2 ? 1024 : 0;
        const int oth = seg < 2 ? 0 : 128;
        u32x4 gsave[8];
#pragma unroll
        for (int ai = 0; ai < 2; ++ai) {
            u32x4 ga[8], gb[8];
            if (ai == 0 || seg < 2) {
#pragma unroll
                for (int m = 0; m < 4; ++m)
#pragma unroll
                    for (int bj = 0; bj < 2; ++bj) { const int gr = row0 + ai * 128 + m * 16, gc = seg * 1024 + col0 + bj * 128;
                        ga[m * 2 + bj] = __builtin_nontemporal_load((const u32x4*)(gates + blk_off(gr, gc, 3072)));     gb[m * 2 + bj] = *(const u32x4*)(gates + blk_off(gr + oth, gc + nxt_off, 3072)); }
            } else {
#pragma unroll
                for (int q = 0; q < 8; ++q) { ga[q] = gsave[q]; gb[q] = gsave[q]; }
            }
            asm volatile("" ::: "memory");
            if (ai == 0) {
#pragma unroll
                for (int q = 0; q < 8; ++q) gsave[q] = gb[q];
            }
#pragma unroll
            for (int m = 0; m < 4; ++m) { const size_t r = (size_t)(row0 + ai * 128 + m * 16);
#pragma unroll
                for (int bj = 0; bj < 2; ++bj) {
                    const u32x4 xa = ga[m * 2 + bj], xb = gb[m * 2 + bj];
                    float g[8] = {bf_lo(xa.x), bf_hi(xa.x), bf_lo(xa.y), bf_hi(xa.y), bf_lo(xa.z), bf_hi(xa.z), bf_lo(xa.w), bf_hi(xa.w)};
                    const float h[8] = {bf_lo(xb.x), bf_hi(xb.x), bf_lo(xb.y), bf_hi(xb.y), bf_lo(xb.z), bf_hi(xb.z), bf_lo(xb.w), bf_hi(xb.w)};
#pragma unroll
                    for (int j = 0; j < 8; ++j) g[j] = __builtin_amdgcn_rcpf(g[j]);
                    f32x4 ga4 = (f32x4){g[0], g[1], g[2], g[3]}, gb4 = (f32x4){g[4], g[5], g[6], g[7]};
                    if (seg < 2) { ga4 = ga4 * (f32x4){h[0], h[1], h[2], h[3]}; gb4 = gb4 * (f32x4){h[4], h[5], h[6], h[7]}; }
                    f32x4 v0 = acc[ai][bj][m][0] * ga4, v1 = acc[ai][bj][m][1] * gb4;
                    if (seg == 2) {
                        u32x4 w; w.x = pk2(v0[0], v0[1]); w.y = pk2(v0[2], v0[3]); w.z = pk2(v1[0], v1[1]); w.w = pk2(v1[2], v1[3]);
                        *(u32x4*)(merged + r * 1024 + col0 + bj * 128) = w;
                        v0 = (f32x4){0.f, 0.f, 0.f, 0.f}; v1 = v0;
                    }
                    acc[ai][bj][m][0] = v0; acc[ai][bj][m][1] = v1; } }
        }
    }
};
struct SchedMerge {
    static constexpr bool GATHER = false; static constexpr bool PROBE = false;
    int K, G, c; const char* a0; const char* b0;
    DI unsigned voffA(int r, int c) const { return pg8::off_plain(r, c, 512); }
    DI unsigned hstepA() const { return 128u * 1024u; }
    DI unsigned kstepA() const { return 128u; }
    DI unsigned voffB(int r, int c) const { return pg8::off_plain(r, c, 512); }
    DI unsigned hstepB() const { return 128u * 1024u; }
    DI unsigned kstepB() const { return 128u; }
    DI unsigned gatherA(const GU&, int, int) const { return 0u; }
    DI bool next(int i, GU& u) const {
        const int tile = i / 3, seg = i - 3 * tile, L = tile * G + c; if (L >= 512) return false;
        int pm, pn; pg8::tile_order(L, 128, 4, pm, pn);
        u.A = a0 + (size_t)seg * (32 * MiB) + (size_t)pm * 256 * 1024; u.B = b0 + (size_t)seg * MiB + (size_t)pn * 256 * 1024; u.p0 = seg; u.p1 = pm; u.p2 = pn; u.p3 = 0; return true;
    }
};
static_assert(WS_ONA == WS_Y + 32 * MiB && WS_OMEM == WS_Y + 64 * MiB && WS_WNAT == WS_WFOT + MiB && WS_WMOT == WS_WFOT + 2 * MiB, "P4 segment strides");

struct EpiOut {
    static constexpr bool PERM = true;
    DI int nstores(const GU&) const { return 16; }
    const float* x; bf16_t* v;
    DI void operator()(Acc& acc, const GU& u, int wr, int wc, int fr, int fq) const {
        const int row0 = u.p1 * 256 + wr * 64 + fr, col0 = u.p2 * 256 + wc * 32 + 8 * fq;
#pragma unroll
        for (int ai = 0; ai < 2; ++ai) {
            f32x4 xv[16];
#pragma unroll
            for (int m = 0; m < 4; ++m) { const size_t off = (size_t)(row0 + ai * 128 + m * 16) * 1024 + col0;
#pragma unroll
                for (int bj = 0; bj < 2; ++bj)
#pragma unroll
                    for (int n = 0; n < 2; ++n) xv[m * 4 + bj * 2 + n] = __builtin_nontemporal_load((const f32x4*)(x + off + bj * 128 + n * 4)); }
            asm volatile("" ::: "memory");
#pragma unroll
            for (int m = 0; m < 4; ++m) { const size_t off = (size_t)(row0 + ai * 128 + m * 16) * 1024 + col0;
#pragma unroll
                for (int bj = 0; bj < 2; ++bj) { const f32x4 v0 = xv[m * 4 + bj * 2] * ALPHA + acc[ai][bj][m][0], v1 = xv[m * 4 + bj * 2 + 1] * ALPHA + acc[ai][bj][m][1];
                    u32x4 w; w.x = pk2(v0[0], v0[1]); w.y = pk2(v0[2], v0[3]); w.z = pk2(v1[0], v1[1]); w.w = pk2(v1[2], v1[3]);
                    *(u32x4*)(v + blk_off(row0 + ai * 128 + m * 16, col0 + bj * 128, 1024)) = w;
                    acc[ai][bj][m][0] = (f32x4){0.f, 0.f, 0.f, 0.f}; acc[ai][bj][m][1] = (f32x4){0.f, 0.f, 0.f, 0.f}; } }
        }
    }
};
struct SchedOut {
    static constexpr bool GATHER = false; static constexpr bool PROBE = false;
    int K, G, c; const char* a; const char* b;
    DI unsigned voffA(int r, int c) const { return pg8::off_plain(r, c, 1024); }
    DI unsigned hstepA() const { return 128u * 2048u; }
    DI unsigned kstepA() const { return 128u; }
    DI unsigned voffB(int r, int c) const { return pg8::off_plain(r, c, 1024); }
    DI unsigned hstepB() const { return 128u * 2048u; }
    DI unsigned kstepB() const { return 128u; }
    DI unsigned gatherA(const GU&, int, int) const { return 0u; }
    DI bool next(int i, GU& u) const {
        const int L = i * G + c; if (L >= 512) return false;
        int pm, pn; pg8::tile_order(L, 128, 4, pm, pn);
        u.A = a + (size_t)pm * 256 * 2048; u.B = b + (size_t)pn * 256 * 2048; u.p0 = 0; u.p1 = pm; u.p2 = pn; u.p3 = 0; return true;
    }
};

DI void moe_tables(const Frame& F) {
    LAS int* tstart = (LAS int*)(F.lds + MISC_OFF + MS_TSTART); LAS int* cnt = (LAS int*)(F.lds + MISC_OFF + MS_CNT);
    LAS unsigned short* tile_e = (LAS unsigned short*)(F.lds + MISC_OFF + MS_TILEE);
    const unsigned* gcnt = (const unsigned*)(F.ws + WS_CTL) + CW_GCNT;
    __syncthreads();
    if (F.tid < 64) { int c = (int)__hip_atomic_load(gcnt + F.tid * GCNT_PAD, __ATOMIC_RELAXED, __HIP_MEMORY_SCOPE_AGENT); c = c > LIST_CAP ? LIST_CAP : c; cnt[F.tid] = c; }
    __syncthreads();
    if (F.tid == 0) { int s = 0; for (int e = 0; e < 64; ++e) { tstart[e] = s; s += (cnt[e] + 255) >> 8; } tstart[64] = s; }
    __syncthreads();
    if (F.tid < 64) { const int e = F.tid; for (int t = tstart[e]; t < tstart[e + 1]; ++t) tile_e[t] = (unsigned short)e; }
    __syncthreads();
}
DI bool moe_unit(int i, int G, int c, int ntiles, int& tau, int& pn) {
    if (G % 8 != 0) { const int L = i * G + c; tau = L >> 2; pn = L & 3; return tau < ntiles; }
    const int x = c & 7, r = c >> 3, per = G >> 3, base = ntiles >> 3, rem = ntiles & 7;
    const int t0 = x * base + (x < rem ? x : rem), cnt = base + (x < rem ? 1 : 0);
    const int u = i * per + r; if (u >= 4 * cnt) return false;
    tau = t0 + (u >> 2); pn = u & 3; return true;
}
struct SchedMoeGU {
    static constexpr bool GATHER = true; static constexpr bool PROBE = false;
    int K, G, c; const char* h; const char* wgu; const int* list; LAS unsigned char* misc;
    DI unsigned voffA(int, int) const { return 0u; }
    DI unsigned hstepA() const { return 0u; }
    DI unsigned kstepA() const { return 128u; }
    DI unsigned voffB(int r, int c) const { return pg8::off_plain(r, c, 1024); }
    DI unsigned hstepB() const { return 128u * 2048u; }
    DI unsigned kstepB() const { return 128u; }
    DI unsigned gatherA(const GU& u, int r, int c) const {
        const LAS int* cnt = (const LAS int*)(misc + MS_CNT);
        const int slot = min(u.p1 * 256 + r, cnt[u.p0] - 1);
        return pg8::off_plain(list[(size_t)u.p0 * LIST_CAP + slot], c, 1024);
    }
    DI bool next(int i, GU& u) const {
        const LAS int* tstart = (const LAS int*)(misc + MS_TSTART); const LAS unsigned short* tile_e = (const LAS unsigned short*)(misc + MS_TILEE);
        int tau, pn; if (!moe_unit(i, G, c, tstart[64], tau, pn)) return false;
        const int e = tile_e[tau];
        u.A = h; u.B = wgu + ((size_t)e * 1024 + 256 * pn) * 2048; u.p0 = e; u.p1 = tau - tstart[e]; u.p2 = pn; u.p3 = tau; return true;
    }
};
struct EpiSwiGLU {
    static constexpr bool PERM = true;
    DI int nstores(const GU&) const { return 8; }
    bf16_t* H;
    DI void operator()(Acc& acc, const GU& u, int wr, int wc, int fr, int fq) const {
        const int row0 = u.p3 * 256 + wr * 64 + fr, col0 = u.p2 * 128 + wc * 32 + 8 * fq;
#pragma unroll
        for (int ai = 0; ai < 2; ++ai)
#pragma unroll
            for (int m = 0; m < 4; ++m) {
                float o[8];
#pragma unroll
                for (int n = 0; n < 2; ++n)
#pragma unroll
                    for (int j = 0; j < 4; ++j) { const float g = acc[ai][0][m][n][j], up = acc[ai][1][m][n][j]; o[4 * n + j] = (g * up) * __builtin_amdgcn_rcpf(1.0f + __builtin_amdgcn_exp2f(g)); }
                u32x4 w; w.x = pk2(o[0], o[1]); w.y = pk2(o[2], o[3]); w.z = pk2(o[4], o[5]); w.w = pk2(o[6], o[7]);
                *(u32x4*)(H + (size_t)(row0 + ai * 128 + m * 16) * 512 + col0) = w;
#pragma unroll
                for (int bj = 0; bj < 2; ++bj)
#pragma unroll
                    for (int n = 0; n < 2; ++n) acc[ai][bj][m][n] = (f32x4){0.f, 0.f, 0.f, 0.f}; }
    }
};
struct SchedMoeD {
    static constexpr bool GATHER = false; static constexpr bool PROBE = false;
    int K, G, c; const char* H; const char* wd; LAS unsigned char* misc;
    DI unsigned voffA(int r, int c) const { return pg8::off_plain(r, c, 512); }
    DI unsigned hstepA() const { return 128u * 1024u; }
    DI unsigned kstepA() const { return 128u; }
    DI unsigned voffB(int r, int c) const { return pg8::off_plain(r, c, 512); }
    DI unsigned hstepB() const { return 128u * 1024u; }
    DI unsigned kstepB() const { return 128u; }
    DI unsigned gatherA(const GU&, int, int) const { return 0u; }
    DI bool next(int i, GU& u) const {
        const LAS int* tstart = (const LAS int*)(misc + MS_TSTART); const LAS unsigned short* tile_e = (const LAS unsigned short*)(misc + MS_TILEE);
        int tau, pn; if (!moe_unit(i, G, c, tstart[64], tau, pn)) return false;
        const int e = tile_e[tau];
        u.A = H + (size_t)tau * 256 * 1024; u.B = wd + ((size_t)e * 1024 + 256 * pn) * 1024; u.p0 = e; u.p1 = 0; u.p2 = pn; u.p3 = tau; return true;
    }
};
struct EpiDown {
    static constexpr bool PERM = true;
    DI int nstores(const GU&) const { return 16; }
    bf16_t* Y;
    DI void operator()(Acc& acc, const GU& u, int wr, int wc, int fr, int fq) const {
        const int row0 = u.p3 * 256 + wr * 64 + fr, col0 = u.p2 * 256 + wc * 32 + 8 * fq;
#pragma unroll
        for (int ai = 0; ai < 2; ++ai)
#pragma unroll
            for (int m = 0; m < 4; ++m) {
#pragma unroll
                for (int bj = 0; bj < 2; ++bj) { const f32x4 v0 = acc[ai][bj][m][0], v1 = acc[ai][bj][m][1];
                    u32x4 w; w.x = pk2(v0[0], v0[1]); w.y = pk2(v0[2], v0[3]); w.z = pk2(v1[0], v1[1]); w.w = pk2(v1[2], v1[3]);
                    __builtin_nontemporal_store(w, (u32x4*)(Y + blk_off(row0 + ai * 128 + m * 16, col0 + bj * 128, 1024)));
                    acc[ai][bj][m][0] = (f32x4){0.f, 0.f, 0.f, 0.f}; acc[ai][bj][m][1] = (f32x4){0.f, 0.f, 0.f, 0.f}; } }
    }
};

#define MFMA16(a, b, c) __builtin_amdgcn_mfma_f32_16x16x32_bf16((a), (b), (c), 0, 0, 0)
template <bool REAL>
DI void fft1_pass(const bf16_t* zt, bf16_t* t1, const LAS unsigned char* fb, int zrow_re, int tch, int n2b, int lane) {
    const int fr = lane & 15, fq = lane >> 4;
    constexpr int NKS = REAL ? 2 : 4;
    f32x4 acc[2][8];
#pragma unroll
    for (int mt = 0; mt < 2; ++mt)
#pragma unroll
        for (int nt = 0; nt < 8; ++nt) acc[mt][nt] = (f32x4){0.f, 0.f, 0.f, 0.f};
    bf16x8 a[NKS][2];
#pragma unroll
    for (int ks = 0; ks < NKS; ++ks) { const int ri = ks >> 1, n1_0 = 32 * (ks & 1) + 8 * fq;
        const int zrow = zrow_re + ri * 64;
#pragma unroll
        for (int mt = 0; mt < 2; ++mt) { const int n2 = n2b + 8 * (fr >> 2) + 4 * mt + (fr & 3);
            a[ks][mt] = __builtin_nontemporal_load((const bf16x8*)(zt + blk_off(zrow, n2 * 64 + n1_0, 8192))); } }
#pragma unroll
    for (int ks = 0; ks < NKS; ++ks)
#pragma unroll
        for (int nt = 0; nt < 8; ++nt) { const bf16x8 bf = *(const LAS bf16x8*)(fb + ((ks * 8 + nt) * 64 + lane) * 16);
#pragma unroll
            for (int mt = 0; mt < 2; ++mt) acc[mt][nt] = MFMA16(a[ks][mt], bf, acc[mt][nt]);
            if (nt == 7) asm volatile("" ::: "memory"); }
#pragma unroll
    for (int ntl = 0; ntl < 4; ++ntl) { const int k1 = 16 * ntl + fr; float ore[8], oim[8];
        const float a0 = (float)(((n2b + 8 * fq) * k1) & 8191) * (1.0f / 8192.0f), da = (float)k1 * (1.0f / 8192.0f);
        float cs = __builtin_amdgcn_cosf(a0), sn = __builtin_amdgcn_sinf(a0); const float dc = __builtin_amdgcn_cosf(da), ds = __builtin_amdgcn_sinf(da);
#pragma unroll
        for (int e = 0; e < 8; ++e) {
            const float re = acc[e >> 2][ntl][e & 3], im = acc[e >> 2][ntl + 4][e & 3];
            ore[e] = re * cs + im * sn; oim[e] = im * cs - re * sn;
            const float c2 = cs * dc - sn * ds; sn = sn * dc + cs * ds; cs = c2; }
        bf16_t* o = t1 + ((size_t)(tch * 2) * 64 + k1) * 128 + n2b + 8 * fq;
        u32x4 w; w.x = pk2(ore[0], ore[1]); w.y = pk2(ore[2], ore[3]); w.z = pk2(ore[4], ore[5]); w.w = pk2(ore[6], ore[7]);
        *(u32x4*)o = w;
        w.x = pk2(oim[0], oim[1]); w.y = pk2(oim[2], oim[3]); w.z = pk2(oim[4], oim[5]); w.w = pk2(oim[6], oim[7]);
        *(u32x4*)(o + 64 * 128) = w; }
}
DI void fft1_item(const bf16_t* zt, bf16_t* t1, const LAS unsigned char* fb, int item, int lane) {
    const int n2h = item & 1, c = (item >> 1) & 63, g = (item >> 7) & 3, b = item >> 9;
    const int zrow = b * 512 + g * 128 + c, tch = (b * 4 + g) * 128 + c;
    if (c == 0) {
#pragma unroll 1
        for (int a2 = 0; a2 < 2; ++a2) fft1_pass<true>(zt, t1, fb, zrow, tch, 64 * n2h + 32 * a2, lane);
    } else {
#pragma unroll 1
        for (int a2 = 0; a2 < 2; ++a2) fft1_pass<false>(zt, t1, fb, zrow, tch, 64 * n2h + 32 * a2, lane);
    }
}
DI void fft1_special(const bf16_t* zt, bf16_t* t1, const LAS unsigned char* fb, int piece, int lane) {
    const int q = piece & 3, g = (piece >> 2) & 3, b = piece >> 4;
    fft1_pass<true>(zt, t1, fb, b * 512 + g * 128 + 64, (b * 4 + g) * 128 + 64, 32 * q, lane);
}
DI void fft2_item(const bf16_t* t1, bf16_t* y, const LAS unsigned char* cb, int item, int lane) {
    const int a2 = item & 1, k1 = (item >> 1) & 63, g = (item >> 7) & 3, b = item >> 9;
    const int fr = lane & 15, fq = lane >> 4;
    f32x4 acc[2][8];
#pragma unroll
    for (int mt = 0; mt < 2; ++mt)
#pragma unroll
        for (int nt = 0; nt < 8; ++nt) acc[mt][nt] = (f32x4){0.f, 0.f, 0.f, 0.f};
#pragma unroll
    for (int kh = 0; kh < 2; ++kh) {
        bf16x8 a[4][2];
#pragma unroll
        for (int kq = 0; kq < 4; ++kq) { const int n2_0 = 32 * kq + 8 * fq;
#pragma unroll
            for (int mt = 0; mt < 2; ++mt) { const int c = 32 * a2 + 8 * (fr >> 2) + 4 * mt + (fr & 3);
                a[kq][mt] = __builtin_nontemporal_load((const bf16x8*)(t1 + ((size_t)((((b * 4 + g) * 128 + c) * 2 + kh) * 64 + k1)) * 128 + n2_0)); } }
#pragma unroll
        for (int kq = 0; kq < 4; ++kq)
#pragma unroll
            for (int nt = 0; nt < 8; ++nt) { const bf16x8 bf = *(const LAS bf16x8*)(cb + (((kh * 4 + kq) * 8 + nt) * 64 + lane) * 16);
#pragma unroll
                for (int mt = 0; mt < 2; ++mt) acc[mt][nt] = MFMA16(a[kq][mt], bf, acc[mt][nt]);
                if (nt == 7) asm volatile("" ::: "memory"); }
    }
    const int c0 = 32 * a2 + 8 * fq;
#pragma unroll
    for (int nt = 0; nt < 8; ++nt) { const int k2 = 16 * nt + fr, k = k1 + 64 * k2; const size_t tok = (size_t)b * 8192 + k, mtok = (size_t)b * 8192 + ((8192 - k) & 8191);
        const f32x4 v0 = acc[0][nt], v1 = acc[1][nt];
        u32x4 w; w.x = pk2(v0[0], v0[1]); w.y = pk2(v0[2], v0[3]); w.z = pk2(v1[0], v1[1]); w.w = pk2(v1[2], v1[3]);
        *(u32x4*)(y + tok * 512 + g * 128 + c0) = w;
        bf16_t* mp = y + mtok * 512 + g * 128 + 128 - c0 - 8;
        mp[1] = (bf16_t)(pk2(v1[3], 0.f) & 0xffffu);
        *(unsigned*)(mp + 2) = pk2(v1[2], v1[1]);
        u32x2 m8; m8.x = pk2(v1[0], v0[3]); m8.y = pk2(v0[2], v0[1]);
        *(u32x2*)(mp + 4) = m8;
        if (c0 != 0) mp[8] = (bf16_t)(pk2(v0[0], 0.f) & 0xffffu);
    }
}
struct Fft2Sp { bf16x8 a[2][4][2]; };
DI void fft2_special_load(Fft2Sp& S, const bf16_t* t1, int piece, int lane) {
    const int k1h = (piece >> 2) & 1, g = (piece >> 3) & 3, b = piece >> 5;
    const int fr = lane & 15, fq = lane >> 4;
    const size_t tbase = (size_t)(((b * 4 + g) * 128 + 64) * 2) * 64 * 128;
#pragma unroll
    for (int kh = 0; kh < 2; ++kh)
#pragma unroll
        for (int kq = 0; kq < 4; ++kq) { const int n2_0 = 32 * kq + 8 * fq;
#pragma unroll
            for (int mt = 0; mt < 2; ++mt) { const int k1 = 32 * k1h + 8 * (fr >> 2) + 4 * mt + (fr & 3);
                S.a[kh][kq][mt] = __builtin_nontemporal_load((const bf16x8*)(t1 + tbase + ((size_t)(kh * 64 + k1)) * 128 + n2_0)); } }
}
DI void fft2_special_compute(const Fft2Sp& S, bf16_t* y, const LAS unsigned char* cb, int piece, int lane) {
    const int ntq = piece & 3, k1h = (piece >> 2) & 1, g = (piece >> 3) & 3, b = piece >> 5;
    const int fr = lane & 15, fq = lane >> 4;
    f32x4 acc[2][2];
#pragma unroll
    for (int mt = 0; mt < 2; ++mt)
#pragma unroll
        for (int n = 0; n < 2; ++n) acc[mt][n] = (f32x4){0.f, 0.f, 0.f, 0.f};
#pragma unroll
    for (int kh = 0; kh < 2; ++kh) {
#pragma unroll
        for (int kq = 0; kq < 4; ++kq)
#pragma unroll
            for (int n = 0; n < 2; ++n) { const bf16x8 bf = *(const LAS bf16x8*)(cb + (((kh * 4 + kq) * 8 + 2 * ntq + n) * 64 + lane) * 16);
#pragma unroll
                for (int mt = 0; mt < 2; ++mt) acc[mt][n] = MFMA16(S.a[kh][kq][mt], bf, acc[mt][n]); }
        asm volatile("" ::: "memory");
    }
#pragma unroll
    for (int n = 0; n < 2; ++n) { const int k2 = 16 * (2 * ntq + n) + fr;
#pragma unroll
        for (int mt = 0; mt < 2; ++mt)
#pragma unroll
            for (int r = 0; r < 4; ++r) { const int k1 = 32 * k1h + 8 * fq + 4 * mt + r;
                y[((size_t)b * 8192 + k1 + 64 * k2) * 512 + g * 128 + 64] = (bf16_t)(pk2(acc[mt][n][r], 0.f) & 0xffffu); } }
}

DI void dma16(const void* gsrc, LAS unsigned char* lds_wave_base) { __builtin_amdgcn_global_load_lds((const unsigned*)gsrc, (LAS unsigned*)lds_wave_base, 16, 0, 0); }
constexpr int NA_KOFF = 0, NA_VOFF = 57344, NA_RPB = 114688, NA_UNITS = 2048;
struct NaUnit { int b, h, s, chf, rb, kc0; };
DI NaUnit na_decode(int uid) { NaUnit u; u.chf = uid & 1; u.s = (uid >> 1) & 31; u.h = (uid >> 6) & 7; u.b = uid >> 9; u.rb = min(max(4 * u.s - 4, 0), 120); u.kc0 = u.chf ? 24 : 0; return u; }
struct NaDesc { unsigned k[7], v[7]; };
DI void na_prep(NaDesc& D, int kc0, int wave, int lane) {
#pragma unroll
    for (int i = 0; i < 7; ++i) { const int p = min(wave + 8 * i, 54), P = p * 64 + lane;
        { const int j = P / 320, rem = P - j * 320, kl = rem >> 3, cpos = rem & 7, chunk = cpos ^ ((kl >> 1) & 7), kk = kc0 + kl;
          D.k[i] = (unsigned)((kk >> 4) * 8192 + (chunk >> 2) * 512 + (kk & 15) * 32 + ((8 * chunk) & 31)) | ((unsigned)j << 20); }
        { const int rowid = P / 5, c5 = P - rowid * 5, j = rowid >> 6, d = rowid & 63, cc = kc0 + 8 * c5;
          D.v[i] = (unsigned)((d >> 4) * 131072 + (cc >> 5) * 512 + (d & 15) * 32 + (cc & 31)) | ((unsigned)j << 20); } }
}
DI void na_stage_k(const NaUnit& u, const NaDesc& D, const bf16_t* k, LAS unsigned char* lds, int wave) {
    const bf16_t* base = k + (size_t)u.b * 4194304 + u.h * 1024;
#pragma unroll
    for (int i = 0; i < 7; ++i) if (i < 6 || wave < 7) { const unsigned d = D.k[i]; const int row = min(u.rb + (int)(d >> 20), 127);
        dma16(base + (size_t)((unsigned)row * 32768u + (d & 0xFFFFFu)), lds + NA_KOFF + (wave + 8 * i) * 1024); }
}
DI void na_stage_v(const NaUnit& u, const NaDesc& D, const bf16_t* vt, LAS unsigned char* lds, int wave) {
    const bf16_t* base = vt + (size_t)(u.b * 32 + u.h * 4) * 131072;
#pragma unroll
    for (int i = 0; i < 7; ++i) if (i < 6 || wave < 7) { const unsigned d = D.v[i]; const int row = min(u.rb + (int)(d >> 20), 127);
        dma16(base + (size_t)((unsigned)row * 1024u + (d & 0xFFFFFu)), lds + NA_VOFF + (wave + 8 * i) * 1024); }
}
DI void na_dma_k(const NaUnit& u, const NaDesc& D, const bf16_t* k, LAS unsigned char* lds, int wave, int i) {
    if (i < 6 || wave < 7) { const unsigned d = D.k[i]; const int row = min(u.rb + (int)(d >> 20), 127);
        dma16(k + (size_t)u.b * 4194304 + u.h * 1024 + (size_t)((unsigned)row * 32768u + (d & 0xFFFFFu)), lds + NA_KOFF + (wave + 8 * i) * 1024); }
}
DI void na_dma_v(const NaUnit& u, const NaDesc& D, const bf16_t* vt, LAS unsigned char* lds, int wave, int i) {
    if (i < 6 || wave < 7) { const unsigned d = D.v[i]; const int row = min(u.rb + (int)(d >> 20), 127);
        dma16(vt + (size_t)(u.b * 32 + u.h * 4) * 131072 + (size_t)((unsigned)row * 1024u + (d & 0xFFFFFu)), lds + NA_VOFF + (wave + 8 * i) * 1024); }
}
DI void na_phase(const Frame& F, const bf16_t* q, const bf16_t* k, const bf16_t* vt, bf16_t* o) {
    LAS unsigned char* lds = F.lds; const LAS float* rpbl = (const LAS float*)(F.lds + NA_RPB);
    int lane = F.lane; asm volatile("" : "+v"(lane));
    const int w = F.wave, fr = lane & 15, fq = lane >> 4;
    const bool bal = (F.G == 256); const int vm = F.vcu & 15;
    const int nun = !bal ? 8 : (vm == 0 ? 5 : ((vm & 3) == 0 ? 9 : 8));
    const int extra = (F.vcu & ~15) + (5 + (vm >> 2) - 1) * 256;
    int ui = 0, uid = F.vcu;
    if (uid >= NA_UNITS) return;
    NaUnit u = na_decode(uid);
    NaDesc D; na_prep(D, u.kc0, w, lane);
    na_stage_k(u, D, k, lds, w);
    bf16x8 qf[2];
    { const int r = 4 * u.s + (w >> 1), jb = 2 * u.chf + (w & 1); const int tq = u.b * 8192 + r * 64 + 16 * jb + fr;
#pragma unroll
      for (int ks = 0; ks < 2; ++ks) qf[ks] = __builtin_nontemporal_load((const bf16x8*)(q + blk_off(tq, u.h * 64 + 32 * ks + 8 * fq, 512))); }
    VM_WAIT(); asm volatile("" : "+v"(qf[0]), "+v"(qf[1]));
    __syncthreads();
    for (;;) {
        const int r = 4 * u.s + (w >> 1), jb = 2 * u.chf + (w & 1);
        const int rs = min(max(r - 4, 0), 120), j0 = rs - u.rb;
        const int w0 = jb == 0 ? 0 : (jb == 1 ? 8 : (jb == 2 ? 24 : 32)), wl = w0 - u.kc0;
        const size_t tokq = (size_t)u.b * 8192 + r * 64 + 16 * jb + fr;
        f32x4 s[8][2];
#pragma unroll
        for (int i = 0; i < 8; ++i) { if (i < 7) na_dma_v(u, D, vt, lds, w, i);
#pragma unroll
            for (int ch = 0; ch < 2; ++ch) { const int kl = wl + 16 * ch + fr, sw = (kl >> 1) & 7;
                const LAS unsigned char* kb = lds + NA_KOFF + ((j0 + i) * 40 + kl) * 128;
                const bf16x8 k0 = *(const LAS bf16x8*)(kb + ((fq ^ sw) * 16)), k1 = *(const LAS bf16x8*)(kb + (((4 + fq) ^ sw) * 16));
                f32x4 z = (f32x4){0.f, 0.f, 0.f, 0.f};
                z = MFMA16(k0, qf[0], z); s[i][ch] = MFMA16(k1, qf[1], z); } }
        const int c = 16 * jb + fr, cs = min(max(c - 8, 0), 48), wofs = cs - w0;
        bool c0[4]; int dcs[4];
#pragma unroll
        for (int rr = 0; rr < 4; ++rr) { c0[rr] = (4 * fq + rr) >= wofs; dcs[rr] = (w0 + 4 * fq + rr + (c0[rr] ? 0 : 16)) - c + 15; }
        float mx = -1e30f;
#pragma unroll
        for (int i = 0; i < 8; ++i) { const LAS float* brow = rpbl + u.h * 480 + (rs + i - r + 7) * 32;
#pragma unroll
            for (int rr = 0; rr < 4; ++rr) { const float v = (c0[rr] ? s[i][0][rr] : s[i][1][rr]) + brow[dcs[rr]]; s[i][0][rr] = v; mx = fmaxf(mx, v); } }
        mx = fmaxf(mx, __shfl_xor(mx, 16)); mx = fmaxf(mx, __shfl_xor(mx, 32));
        float l = 0.f;
        u32x4 pw[8];
        const unsigned mA = (c0[0] ? 0xffffu : 0u) | (c0[1] ? 0xffff0000u : 0u), mB = (c0[2] ? 0xffffu : 0u) | (c0[3] ? 0xffff0000u : 0u), nA = ~mA, nB = ~mB;
#pragma unroll
        for (int i = 0; i < 8; ++i) { float p[4];
#pragma unroll
            for (int rr = 0; rr < 4; ++rr) { p[rr] = __builtin_amdgcn_exp2f(s[i][0][rr] - mx); l += p[rr]; }
            const unsigned pa = pk2(p[0], p[1]), pb = pk2(p[2], p[3]);
            pw[i].x = pa & mA; pw[i].y = pb & mB; pw[i].z = pa & nA; pw[i].w = pb & nB; }
        l += __shfl_xor(l, 16); l += __shfl_xor(l, 32);
        const float inv = 1.0f / l;
        VM_WAIT(); __syncthreads();
        ++ui; const int nuid = !bal ? uid + F.G : (ui < 8 ? F.vcu + 256 * ui : extra); const bool has_next = !bal ? (nuid < NA_UNITS) : (ui < nun);
        NaUnit nu = u;
        if (has_next) { nu = na_decode(nuid); if (nu.kc0 != u.kc0) na_prep(D, nu.kc0, w, lane);
            const int nr = 4 * nu.s + (w >> 1), njb = 2 * nu.chf + (w & 1); const int tq = nu.b * 8192 + nr * 64 + 16 * njb + fr;
#pragma unroll
            for (int ks = 0; ks < 2; ++ks) qf[ks] = __builtin_nontemporal_load((const bf16x8*)(q + blk_off(tq, nu.h * 64 + 32 * ks + 8 * fq, 512))); }
        f32x4 oacc[4];
#pragma unroll
        for (int dt = 0; dt < 4; ++dt) oacc[dt] = (f32x4){0.f, 0.f, 0.f, 0.f};
#pragma unroll
        for (int i = 0; i < 8; ++i) { const bf16x8 pf = __builtin_bit_cast(bf16x8, pw[i]);
            if (i < 7 && has_next) na_dma_k(nu, D, k, lds, w, i);
#pragma unroll
            for (int dt = 0; dt < 4; ++dt) { const LAS unsigned char* vb = lds + NA_VOFF + ((j0 + i) * 64 + 16 * dt + fr) * 80 + (wl + 4 * fq) * 2;
                const u32x2 lo = *(const LAS u32x2*)vb, hi = *(const LAS u32x2*)(vb + 32);
                u32x4 vw; vw.x = lo.x; vw.y = lo.y; vw.z = hi.x; vw.w = hi.y;
                oacc[dt] = MFMA16(__builtin_bit_cast(bf16x8, vw), pf, oacc[dt]); } }
        asm volatile("s_waitcnt vmcnt(0)" ::: "memory");
        asm volatile("" : "+v"(qf[0]), "+v"(qf[1]));
#pragma unroll
        for (int dt = 0; dt < 4; ++dt) { u32x2 wv; wv.x = pk2(oacc[dt][0] * inv, oacc[dt][1] * inv); wv.y = pk2(oacc[dt][2] * inv, oacc[dt][3] * inv);
            *(u32x2*)(o + tokq * 512 + u.h * 64 + 16 * dt + 4 * fq) = wv; }
        asm volatile("s_waitcnt lgkmcnt(0)" ::: "memory"); __builtin_amdgcn_s_barrier(); asm volatile("" ::: "memory");
        if (!has_next) break;
        uid = nuid; u = nu;
    }
    VM_WAIT(); __syncthreads();
}
DI void mem_phase(const Frame& F, const bf16_t* qm, const bf16_t* km, const bf16_t* vtm, bf16_t* o) {
    LAS unsigned char* lds = F.lds; const int lane = F.lane, w = F.wave, fr = lane & 15, fq = lane >> 4;
    if (F.tid == 0) { unsigned* cnt = (unsigned*)(F.ws + WS_CTL) + CW_KVDONE; unsigned* tmo = (unsigned*)(F.ws + WS_CTL) + CW_BAR + XB_TMO; unsigned sp = 0;
        while (xb_ld(cnt) < 16u) { __builtin_amdgcn_s_sleep(2); if ((++sp & 255u) == 0u) { if (xb_ld(tmo)) break; if (sp > (1u << 20)) { atomicAdd(tmo, 1u); break; } } }
        __builtin_amdgcn_fence(__ATOMIC_ACQUIRE, "agent"); asm volatile("s_waitcnt vmcnt(0)" ::: "memory"); }
    __syncthreads();
    for (int chunk = F.vcu; chunk < 256; chunk += F.G) {
        const int pair = chunk >> 4, b = pair >> 2, h = pair & 3, qc = chunk & 15;
        for (int i = 0; i < 8; ++i) { const int p = w + 8 * i, P = p * 64 + lane;
            { const int key = P >> 4, cpos = P & 15, c = cpos ^ (key & 15); dma16(km + blk_off(b * 256 + key, h * 128 + 8 * c, 512), lds + p * 1024); }
            { const int d = P >> 5, cpos = P & 31, c = cpos ^ (d & 15); dma16(vtm + blk_off(b * 512 + h * 128 + d, 8 * c, 256), lds + 65536 + p * 1024); } }
        bf16x8 qn[4];
        { const size_t tq0 = (size_t)b * 8192 + qc * 512 + w * 64 + fr;
#pragma unroll
          for (int ks = 0; ks < 4; ++ks) qn[ks] = __builtin_nontemporal_load((const bf16x8*)(qm + blk_off((int)tq0, h * 128 + 32 * ks + 8 * fq, 512))); }
        VM_WAIT(); __syncthreads();
#pragma unroll 1
        for (int pass = 0; pass < 4; ++pass) {
            asm volatile("" ::: "memory");
            const size_t tokq = (size_t)b * 8192 + qc * 512 + w * 64 + pass * 16 + fr;
            bf16x8 qf[4];
#pragma unroll
            for (int ks = 0; ks < 4; ++ks) qf[ks] = qn[ks];
            { const size_t tqn = (size_t)b * 8192 + qc * 512 + w * 64 + min(pass + 1, 3) * 16 + fr;
#pragma unroll
              for (int ks = 0; ks < 4; ++ks) qn[ks] = __builtin_nontemporal_load((const bf16x8*)(qm + blk_off((int)tqn, h * 128 + 32 * ks + 8 * fq, 512))); }
            f32x4 s[16];
#pragma unroll
            for (int kt = 0; kt < 16; ++kt) { const LAS unsigned char* kb = lds + (16 * kt + fr) * 256;
                f32x4 z0 = (f32x4){0.f, 0.f, 0.f, 0.f};
#pragma unroll
                for (int ks = 0; ks < 4; ++ks) { const bf16x8 kf = *(const LAS bf16x8*)(kb + (((4 * ks + fq) ^ fr) * 16)); z0 = MFMA16(kf, qf[ks], z0); }
                s[kt] = z0; if ((kt & 3) == 3) asm volatile("" ::: "memory"); }
            u32x4 pw[8];
            float mx = -1e30f;
#pragma unroll
            for (int kt = 0; kt < 16; ++kt)
#pragma unroll
                for (int rr = 0; rr < 4; ++rr) mx = fmaxf(mx, s[kt][rr]);
            mx = fmaxf(mx, __shfl_xor(mx, 16)); mx = fmaxf(mx, __shfl_xor(mx, 32));
            float l = 0.f;
#pragma unroll
            for (int u = 0; u < 8; ++u) { float p[8];
#pragma unroll
                for (int e = 0; e < 8; ++e) { p[e] = __builtin_amdgcn_exp2f(s[2 * u + (e >> 2)][e & 3] - mx); l += p[e]; }
                pw[u].x = pk2(p[0], p[1]); pw[u].y = pk2(p[2], p[3]); pw[u].z = pk2(p[4], p[5]); pw[u].w = pk2(p[6], p[7]); }
            l += __shfl_xor(l, 16); l += __shfl_xor(l, 32);
            const float inv = 1.0f / l;
            f32x4 oacc[8];
#pragma unroll
            for (int dt = 0; dt < 8; ++dt) oacc[dt] = (f32x4){0.f, 0.f, 0.f, 0.f};
#pragma unroll
            for (int u = 0; u < 8; ++u)
#pragma unroll
                for (int dt = 0; dt < 8; ++dt) { const LAS unsigned char* vb = lds + 65536 + (16 * dt + fr) * 512;
                    const u32x2 lo = *(const LAS u32x2*)(vb + (((8 * u + fq) ^ (fr << 1)) * 8)), hi = *(const LAS u32x2*)(vb + (((8 * u + 4 + fq) ^ (fr << 1)) * 8));
                    u32x4 vw; vw.x = lo.x; vw.y = lo.y; vw.z = hi.x; vw.w = hi.y;
                    oacc[dt] = MFMA16(__builtin_bit_cast(bf16x8, vw), __builtin_bit_cast(bf16x8, pw[u]), oacc[dt]);
                    if (dt == 7) asm volatile("" ::: "memory"); }
#pragma unroll
            for (int dt = 0; dt < 8; ++dt) { u32x2 wv; wv.x = pk2(oacc[dt][0] * inv, oacc[dt][1] * inv); wv.y = pk2(oacc[dt][2] * inv, oacc[dt][3] * inv);
                *(u32x2*)(o + tokq * 512 + h * 128 + 16 * dt + 4 * fq) = wv; }
        }
        __syncthreads();
    }
}

DI void p7_stage_wr(const bf16_t* wrt, LAS unsigned char* lds, int half, int w, int lane) {
    for (int i = 0; i < 10; ++i) { const int p = w + 8 * i, P = p * 64 + lane, row = P >> 6, cpos = P & 63, c = (cpos & ~15) | ((cpos ^ row) & 15);
        dma16(wrt + (size_t)row * 1024 + half * 512 + 8 * c, lds + p * 1024); }
}
DI void p6_ln_router(const Frame& F, const Args& a) {
    unsigned char* ws = F.ws; int lane = F.lane; asm volatile("" : "+v"(lane)); const int w = F.wave, fr = lane & 15, fq = lane >> 4;
    const bf16_t* v = (const bf16_t*)(ws + WS_V); bf16_t* h = (bf16_t*)(ws + WS_H); const bf16_t* wrt = (const bf16_t*)(ws + WS_WRT);
    unsigned* gcnt = (unsigned*)(ws + WS_CTL) + CW_GCNT; int* list = (int*)(ws + WS_LIST); unsigned* rec = (unsigned*)(ws + WS_REC);
    LAS unsigned char* lds = F.lds;
    LAS float* lg = (LAS float*)(F.lds + 81920 + w * 5120);
    LAS float* gbl = (LAS float*)(F.lds + 122880);
    LAS int* hist = (LAS int*)(F.lds + MISC_OFF + MS_HIST); LAS int* base = (LAS int*)(F.lds + MISC_OFF + MS_BASE);
    LAS float* rbl = (LAS float*)(F.lds + MISC_OFF + 4096);
    for (int chunk = F.vcu; chunk < T / 128; chunk += F.G) {
        const int tok0 = chunk * 128 + 16 * w;
        if (F.tid < 64) hist[F.tid] = 0;
        __syncthreads();
        { int lane1 = lane; asm volatile("" : "+v"(lane1)); p7_stage_wr(wrt, lds, 0, w, lane1); }
        f32x4 acc[5];
#pragma unroll
        for (int mt = 0; mt < 5; ++mt) acc[mt] = (f32x4){0.f, 0.f, 0.f, 0.f};
        { const bf16_t* vb = v + (size_t)(tok0 >> 4) * 32 * 512 + fr * 32 + fq * 8;
          u32x4 d[32];
#pragma unroll
          for (int b = 0; b < 32; ++b) d[b] = __builtin_nontemporal_load((const u32x4*)(vb + b * 512));
          { int t_ = F.tid; asm volatile("" : "+v"(t_));
            for (int i = t_; i < 1024; i += 512) { gbl[i] = a.in[IN_LN1G][i]; gbl[1024 + i] = a.in[IN_LN1B][i]; }
            if (t_ < 8) rbl[t_] = a.in[IN_BRG][t_]; else if (t_ < 72) rbl[t_] = a.in[IN_BRE][t_ - 8]; }
          float s, q;
          { typedef __bf16 bf2_t __attribute__((ext_vector_type(2)));
            const bf2_t ones = __builtin_bit_cast(bf2_t, 0x3f803f80u); float sa = 0.f, sb = 0.f, qa = 0.f, qb = 0.f;
#pragma unroll
            for (int b = 0; b < 32; ++b) { const unsigned wd[4] = {d[b].x, d[b].y, d[b].z, d[b].w};
#pragma unroll
                for (int j = 0; j < 4; j += 2) { const bf2_t x0 = __builtin_bit_cast(bf2_t, wd[j]), x1 = __builtin_bit_cast(bf2_t, wd[j + 1]);
                    sa = __builtin_amdgcn_fdot2_f32_bf16(x0, ones, sa, false); sb = __builtin_amdgcn_fdot2_f32_bf16(x1, ones, sb, false);
                    qa = __builtin_amdgcn_fdot2_f32_bf16(x0, x0, qa, false); qb = __builtin_amdgcn_fdot2_f32_bf16(x1, x1, qb, false); } }
            s = sa + sb; q = qa + qb; }
#pragma unroll
          for (int b = 0; b < 16; ++b) asm volatile("" : "+v"(d[b]));
          s += __shfl_xor(s, 16); s += __shfl_xor(s, 32); q += __shfl_xor(q, 16); q += __shfl_xor(q, 32);
          const float mean = s * (1.0f / 1024.0f);
          const float rstd = 1.0f / sqrtf(fmaxf(q * (1.0f / 1024.0f) - mean * mean, 0.f) + LN_EPS), nmr = -mean * rstd;
          bf16_t* hrow = h + (size_t)(tok0 + fr) * 1024 + 8 * fq;
          VM_WAIT(); __syncthreads();
#pragma unroll
          for (int half = 0; half < 2; ++half) {
              if (half) { __syncthreads(); int lane2 = lane; asm volatile("" : "+v"(lane2)); p7_stage_wr(wrt, lds, 1, w, lane2);
                  const bf16_t* vb2 = v + (size_t)(tok0 >> 4) * 32 * 512 + (lane2 & 15) * 32 + (lane2 >> 4) * 8;
#pragma unroll
                  for (int b = 0; b < 16; ++b) d[b] = __builtin_nontemporal_load((const u32x4*)(vb2 + (16 + b) * 512));
                  VM_WAIT(); __syncthreads(); }
#pragma unroll
              for (int b = 0; b < 16; ++b) { const int blk = half * 16 + b, col = 32 * blk + 8 * fq;
                  const u32x4 dv = d[b];
                  const f32x4 g0 = *(const LAS f32x4*)(gbl + col), g1 = *(const LAS f32x4*)(gbl + col + 4), b0 = *(const LAS f32x4*)(gbl + 1024 + col), b1 = *(const LAS f32x4*)(gbl + 1024 + col + 4);
                  u32x4 o;
                  { const f32x2 r2 = (f32x2){rstd, rstd}, n2 = (f32x2){nmr, nmr};
                    f32x2 p0 = (f32x2){bf_lo(dv.x), bf_hi(dv.x)} * r2 + n2, p1 = (f32x2){bf_lo(dv.y), bf_hi(dv.y)} * r2 + n2, p2 = (f32x2){bf_lo(dv.z), bf_hi(dv.z)} * r2 + n2, p3 = (f32x2){bf_lo(dv.w), bf_hi(dv.w)} * r2 + n2;
                    p0 = p0 * (f32x2){g0[0], g0[1]} + (f32x2){b0[0], b0[1]}; p1 = p1 * (f32x2){g0[2], g0[3]} + (f32x2){b0[2], b0[3]};
                    p2 = p2 * (f32x2){g1[0], g1[1]} + (f32x2){b1[0], b1[1]}; p3 = p3 * (f32x2){g1[2], g1[3]} + (f32x2){b1[2], b1[3]};
                    o.x = pk2(p0[0], p0[1]); o.y = pk2(p1[0], p1[1]); o.z = pk2(p2[0], p2[1]); o.w = pk2(p3[0], p3[1]); }
                  *(u32x4*)(hrow + 32 * blk) = o;
                  int fro = fr; asm volatile("" : "+v"(fro));
                  const bf16x8 bfr = __builtin_bit_cast(bf16x8, o); const int ch = 4 * b + fq, cpos = (ch & ~15) | ((ch ^ fro) & 15);
#pragma unroll
                  for (int mt = 0; mt < 5; ++mt) acc[mt] = MFMA16(*(const LAS bf16x8*)(lds + (16 * mt + fro) * 1024 + cpos * 16), bfr, acc[mt]);
                  asm volatile("" ::: "memory"); }
          } }
#pragma unroll
        for (int mt = 0; mt < 5; ++mt)
#pragma unroll
            for (int rr = 0; rr < 4; ++rr) lg[fr * 80 + 16 * mt + 4 * fq + rr] = acc[mt][rr];
        LDS_WAIT(); asm volatile("" ::: "memory");
        int e1 = 0, e2 = 0, l1 = 0, l2 = 0; float w1 = 0.f, w2 = 0.f;
        int lane3 = lane; asm volatile("" : "+v"(lane3));
        if (lane3 < 16) {
            const LAS float* L = lg + lane3 * 80;
            float gl[8]; int gi = 0; float gm;
#pragma unroll
            for (int j = 0; j < 8; ++j) gl[j] = L[64 + j] + rbl[j];
            gm = gl[0];
#pragma unroll
            for (int j = 1; j < 8; ++j) if (gl[j] > gm) { gm = gl[j]; gi = j; }
            float se = 0.f;
#pragma unroll
            for (int j = 0; j < 8; ++j) se += __expf(gl[j] - gm);
            const float pg = 1.0f / se;
            float el[8];
#pragma unroll
            for (int j = 0; j < 8; ++j) el[j] = L[gi * 8 + j] + rbl[8 + gi * 8 + j];
            int i1 = 0; float v1 = el[0];
#pragma unroll
            for (int j = 1; j < 8; ++j) if (el[j] > v1) { v1 = el[j]; i1 = j; }
            int i2 = -1; float v2 = -3.0e38f;
#pragma unroll
            for (int j = 0; j < 8; ++j) if (j != i1 && el[j] > v2) { v2 = el[j]; i2 = j; }
            const float t = __expf(v2 - v1); const float p1 = 1.0f / (1.0f + t);
            w1 = p1 * pg; w2 = (t * p1) * pg; e1 = gi * 8 + i1; e2 = gi * 8 + i2;
            l1 = __hip_atomic_fetch_add(&hist[e1], 1, __ATOMIC_RELAXED, __HIP_MEMORY_SCOPE_WORKGROUP); l2 = __hip_atomic_fetch_add(&hist[e2], 1, __ATOMIC_RELAXED, __HIP_MEMORY_SCOPE_WORKGROUP);
        }
        __syncthreads();
        if (F.tid < 64) { const int c = hist[F.tid]; base[F.tid] = c > 0 ? (int)atomicAdd(gcnt + F.tid * GCNT_PAD, (unsigned)c) : 0; }
        __syncthreads();
        if (lane3 < 16) { const int tok = tok0 + lane3; const int s1 = base[e1] + l1, s2 = base[e2] + l2;
            if (s1 < LIST_CAP) list[(size_t)e1 * LIST_CAP + s1] = tok;
            if (s2 < LIST_CAP) list[(size_t)e2 * LIST_CAP + s2] = tok;
            u32x4 r0; r0.x = (unsigned)e1; r0.y = (unsigned)s1; r0.z = (unsigned)e2; r0.w = (unsigned)s2;
            *(u32x4*)(rec + (size_t)tok * 8) = r0;
            u32x2 r1; r1.x = __float_as_uint(w1); r1.y = __float_as_uint(w2); *(u32x2*)(rec + (size_t)tok * 8 + 4) = r1; }
        __syncthreads();
    }
}

DI void p9_combine(const Frame& F, const Args& a) {
    unsigned char* ws = F.ws; const int lane = F.lane;
    const bf16_t* h = (const bf16_t*)(ws + WS_H); const bf16_t* yb = (const bf16_t*)(ws + WS_YB); const unsigned* rec = (const unsigned*)(ws + WS_REC);
    const LAS int* tstart = (const LAS int*)(F.lds + MISC_OFF + MS_TSTART);
    f32x4 gv[4], bv[4];
#pragma unroll
    for (int j = 0; j < 4; ++j) { gv[j] = *(const f32x4*)(a.in[IN_LN2G] + 4 * lane + 256 * j); bv[j] = *(const f32x4*)(a.in[IN_LN2B] + 4 * lane + 256 * j); }
    const int gw = F.vcu * 8 + F.wave, NGW = F.G * 8;
    for (int t = gw; t < T; t += NGW) {
        const u32x4 r0 = *(const u32x4*)(rec + (size_t)t * 8); const u32x2 r1 = *(const u32x2*)(rec + (size_t)t * 8 + 4);
        const size_t row1 = (size_t)tstart[r0.x] * 256 + r0.y, row2 = (size_t)tstart[r0.z] * 256 + r0.w;
        const float w1 = __uint_as_float(r1.x), w2 = __uint_as_float(r1.y);
        f32x4 x[4]; float s = 0.f;
#pragma unroll
        for (int j = 0; j < 4; ++j) { const int col = 4 * lane + 256 * j;
            const u32x2 hv = __builtin_nontemporal_load((const u32x2*)(h + (size_t)t * 1024 + col)), y1 = __builtin_nontemporal_load((const u32x2*)(yb + blk_off((int)row1, col, 1024))), y2 = __builtin_nontemporal_load((const u32x2*)(yb + blk_off((int)row2, col, 1024)));
            { const f32x2 a2 = (f32x2){ALPHA, ALPHA}, w1v = (f32x2){w1, w1}, w2v = (f32x2){w2, w2};
              const f32x2 pa = (f32x2){bf_lo(hv.x), bf_hi(hv.x)} * a2 + ((f32x2){bf_lo(y1.x), bf_hi(y1.x)} * w1v + (f32x2){bf_lo(y2.x), bf_hi(y2.x)} * w2v);
              const f32x2 pb = (f32x2){bf_lo(hv.y), bf_hi(hv.y)} * a2 + ((f32x2){bf_lo(y1.y), bf_hi(y1.y)} * w1v + (f32x2){bf_lo(y2.y), bf_hi(y2.y)} * w2v);
              x[j][0] = pa[0]; x[j][1] = pa[1]; x[j][2] = pb[0]; x[j][3] = pb[1];
              const f32x2 ps = pa + pb; s += ps[0] + ps[1]; } }
        const float mean = wave_sum(s) * (1.0f / 1024.0f); float s2 = 0.f;
#pragma unroll
        for (int j = 0; j < 4; ++j) { x[j] = x[j] - mean; s2 += (x[j][0] * x[j][0] + x[j][1] * x[j][1]) + (x[j][2] * x[j][2] + x[j][3] * x[j][3]); }
        const float rstd = 1.0f / sqrtf(wave_sum(s2) * (1.0f / 1024.0f) + LN_EPS);
#pragma unroll
        for (int j = 0; j < 4; ++j) __builtin_nontemporal_store(x[j] * rstd * gv[j] + bv[j], (f32x4*)(a.out + (size_t)t * 1024 + 4 * lane + 256 * j));
    }
}

constexpr int N_PHASES = 11;
__global__ void __launch_bounds__(512, 2) mk_fwd(Args args) {
    extern __shared__ __attribute__((aligned(16))) unsigned char lds_raw[];
    Frame F;
    F.lds = (LAS unsigned char*)lds_raw;
    F.tid = threadIdx.x; F.lane = F.tid & 63; F.wave = __builtin_amdgcn_readfirstlane(F.tid >> 6);
    F.G = gridDim.x; { const int bx = blockIdx.x; F.vcu = (F.G % 8 == 0) ? (bx % 8) * (F.G / 8) + bx / 8 : bx; }
    F.ws = args.ws;
    unsigned char* ws = args.ws;
    for (int u = F.tid; u < (LDS_BYTES - MISC_OFF) / 4; u += 512) ((LAS unsigned*)(F.lds + MISC_OFF))[u] = 0u;
    __syncthreads();
    const int lo = args.ph_lo, hi = args.ph_hi;
    XcdBarrier bar; bar.bar = (unsigned*)(ws + WS_CTL) + CW_BAR; bar.x = 0; bar.st = nullptr;
    if (hi - lo > 1) bar = xcd_barrier_post((unsigned*)(ws + WS_CTL) + CW_BAR, (volatile LAS unsigned*)(F.lds + MISC_OFF + MS_BAR));
#ifndef PH_MASK
#define PH_MASK 0xffff
#endif
#ifndef PROBE_TWICE
#define PROBE_TWICE -1
#endif
#define IN(k) (((PH_MASK >> (k)) & 1) && lo <= (k) && (k) < hi)
#define REP(k) for (int rep_ = 0; rep_ < ((k) == PROBE_TWICE ? 2 : 1); ++rep_)
#define SEAM(k) do { if (IN(k) && IN((k) + 1)) xcd_barrier(bar); } while (0)
    const int cid = (int)blockIdx.x;

    if (IN(0)) REP(0) { p0_prologue(F, args); }
    SEAM(0);
    if (IN(1)) REP(1) {
        { SchedP1F S{1024, F.G, cid, (const char*)(ws + WS_XB), (const char*)(ws + WS_W1T)}; EpiP1<false> E{ws, args.in[IN_BGATE]};
          pg8::gemm_phase<EpiP1<false>, SchedP1F>(F.lds, S, E); }
        { SchedP1g S{1024, F.G, cid, (const char*)(ws + WS_XB), (const char*)(ws + WS_W1T)}; EpiP1<true> E{ws, args.in[IN_BGATE]};
          pg8::gemm_phase<EpiP1<true>, SchedP1g>(F.lds, S, E); }
        { SchedP1a S{1024, F.G, cid, (const char*)(ws + WS_XB), (const char*)(ws + WS_W1T), (const char*)(ws + WS_MEMB), (const char*)(ws + WS_WKVT)}; EpiP1<false> E{ws, args.in[IN_BGATE]};
          pg8::gemm_phase<EpiP1<false>, SchedP1a>(F.lds, S, E); }
    }
    SEAM(1);
    if (IN(2)) REP(2) {
        __syncthreads();
        const int gw = F.vcu * 8 + F.wave, NGW = F.G * 8;
        { const int kvj = (F.G == 256) ? ((F.vcu & 15) == 0 ? (F.vcu >> 4) : -1) : (F.vcu < 16 ? F.vcu : -1);
          SchedKV S{1024, kvj, (const char*)(ws + WS_MEMB), (const char*)(ws + WS_WKVT)}; EpiP1<false> E{ws, args.in[IN_BGATE]};
          pg8::gemm_phase<EpiP1<false>, SchedKV>(F.lds, S, E);
          if (kvj >= 0) { VM_WAIT(); __syncthreads();
              if (F.tid == 0) { __builtin_amdgcn_fence(__ATOMIC_RELEASE, "agent"); asm volatile("s_waitcnt vmcnt(0)" ::: "memory"); (void)xb_add((unsigned*)(ws + WS_CTL) + CW_KVDONE, 1u); }
              __syncthreads(); } }
        { LAS unsigned char* fb = F.lds;
          for (int i = F.tid; i < 2048; i += 512) *(LAS u32x4*)(fb + i * 16) = *(const u32x4*)(ws + WS_F64 + (size_t)i * 16);
          __syncthreads();
          for (int it = gw; it < 2048; it += NGW) fft1_item((const bf16_t*)(ws + WS_ZT), (bf16_t*)(ws + WS_T1), fb, it, F.lane);
          { const int sp = NGW >= 64 ? NGW / 64 : 1, off = sp >= 16 ? 8 : 0;
            if (gw % sp == off) for (int pc = gw / sp; pc < 64; pc += (NGW + sp - 1) / sp) fft1_special((const bf16_t*)(ws + WS_ZT), (bf16_t*)(ws + WS_T1), fb, pc, F.lane); }
          __syncthreads(); }
        { LAS float* rpbl = (LAS float*)(F.lds + NA_RPB);
          for (int i = F.tid; i < 8 * 15 * 32; i += 512) { const int dc = i & 31, dr = (i >> 5) % 15, hh = i / 480; rpbl[i] = dc < 31 ? args.in[IN_RPB][(hh * 15 + dr) * 31 + dc] * 1.4426950408889634f : 0.f; }
          __syncthreads();
          na_phase(F, (const bf16_t*)(ws + WS_Q), (const bf16_t*)(ws + WS_K), (const bf16_t*)(ws + WS_VT), (bf16_t*)(ws + WS_ONA)); }
        mem_phase(F, (const bf16_t*)(ws + WS_QM), (const bf16_t*)(ws + WS_KVM), (const bf16_t*)(ws + WS_KVM + MiB), (bf16_t*)(ws + WS_OMEM));
    }
    SEAM(2);
    if (IN(3)) REP(3) {
        LAS unsigned char* cb = F.lds;
        for (int i = F.tid; i < 4096; i += 512) *(LAS u32x4*)(cb + i * 16) = *(const u32x4*)(ws + WS_C128 + (size_t)i * 16);
        __syncthreads();
        const int gw = F.vcu * 8 + F.wave, NGW = F.G * 8;
        { const int sp = NGW >= 128 ? NGW / 128 : 1, pc0 = gw / sp; const bool has_sp = (gw % sp == 0) && pc0 < 128;
          Fft2Sp SP;
          if (has_sp) fft2_special_load(SP, (const bf16_t*)(ws + WS_T1), pc0, F.lane);
          for (int it = gw; it < 2048; it += NGW) fft2_item((const bf16_t*)(ws + WS_T1), (bf16_t*)(ws + WS_Y), cb, it, F.lane);
          if (has_sp) { fft2_special_compute(SP, (bf16_t*)(ws + WS_Y), cb, pc0, F.lane);
              for (int pc = pc0 + (NGW + sp - 1) / sp; pc < 128; pc += (NGW + sp - 1) / sp) { fft2_special_load(SP, (const bf16_t*)(ws + WS_T1), pc, F.lane); fft2_special_compute(SP, (bf16_t*)(ws + WS_Y), cb, pc, F.lane); } } }
        __syncthreads();
    }
    SEAM(3);
    if (IN(4)) REP(4) {
        SchedMerge S{512, F.G, cid, (const char*)(ws + WS_Y), (const char*)(ws + WS_WFOT)};
        EpiMerge E{(const bf16_t*)(ws + WS_GATES), (bf16_t*)(ws + WS_MERGED)};
        pg8::gemm_phase<EpiMerge, SchedMerge>(F.lds, S, E);
    }
    SEAM(4);
    if (IN(5)) REP(5) {
        const bool cvt_first = (F.vcu & 1) != 0;
        if (cvt_first) p_expert_cvt_gu(F, args, true);
        __syncthreads();
        { SchedOut S{1024, F.G, cid, (const char*)(ws + WS_MERGED), (const char*)(ws + WS_WOUTT)}; EpiOut E{args.in[IN_X], (bf16_t*)(ws + WS_V)};
          pg8::gemm_phase<EpiOut, SchedOut>(F.lds, S, E); }
        __syncthreads();
        if (!cvt_first) p_expert_cvt_gu(F, args, false);
    }
    SEAM(5);
    if (IN(6)) { }
    if (IN(6) && IN(7)) { }
    if (IN(7)) { p6_ln_router(F, args); }
    SEAM(7);
    if (IN(8)) REP(8) {
        moe_tables(F);
        int part = -1, nparts = 1;
        if (F.G % 8 == 0) {
            const int ntl = ((const LAS int*)(F.lds + MISC_OFF + MS_TSTART))[64], per = F.G >> 3, base = ntl >> 3, rem = ntl & 7, x = cid & 7, r = cid >> 3;
            nparts = 0;
            for (int xx = 0; xx < 8; ++xx) { const int ex = (4 * (base + (xx < rem ? 1 : 0))) % per;
                if (xx == x && r >= ex) part = nparts + (r - ex);
                nparts += per - ex; }
        } else if (F.G >= 2) { if (cid >= F.G / 2) part = cid - F.G / 2; nparts = F.G - F.G / 2; } else part = 0;
        if (part >= 0) p_expert_cvt_down(F, args, part, nparts, 0, NEXP * 128);
        __syncthreads();
        SchedMoeGU S{1024, F.G, cid, (const char*)(ws + WS_H), (const char*)(ws + WS_WGUT), (const int*)(ws + WS_LIST), F.lds + MISC_OFF}; EpiSwiGLU E{(bf16_t*)(ws + WS_HMOE)};
        pg8::gemm_phase<EpiSwiGLU, SchedMoeGU>(F.lds, S, E);
        __syncthreads();
        if (part >= 0) p_expert_cvt_down(F, args, part, nparts, NEXP * 128, NEXP * 256);
    }
    SEAM(8);
    if (IN(9)) REP(9) {
        moe_tables(F);
        SchedMoeD S{512, F.G, cid, (const char*)(ws + WS_HMOE), (const char*)(ws + WS_WDT), F.lds + MISC_OFF}; EpiDown E{(bf16_t*)(ws + WS_YB)};
        pg8::gemm_phase<EpiDown, SchedMoeD>(F.lds, S, E);
    }
    SEAM(9);
    if (IN(10)) REP(10) { moe_tables(F); p9_combine(F, args); }
#ifdef PROBE_SEL
    __syncthreads();
    if (blockIdx.x == PROBE_BLOCK && F.tid == 0) { const unsigned long long d = *(LAS unsigned long long*)(F.lds + MISC_OFF + 3072) * PROBE_SCALE; const unsigned long long t0 = __builtin_amdgcn_s_memrealtime();
        while (__builtin_amdgcn_s_memrealtime() - t0 < d) __builtin_amdgcn_s_sleep(16); }
#endif
#undef IN
#undef SEAM
#undef REP
}

#ifndef MK_PER_PHASE
#define MK_PER_PHASE 0
#endif
extern "C" void kernel_launch(void* const* d_in, const int* in_sizes, int n_in, void* d_out, int out_size, void* d_ws, size_t ws_size, hipStream_t stream) {
    static int grid = 0;
    if (grid == 0) {
        if (n_in != 22 || in_sizes[0] != T * DM || out_size != T * DM || ws_size < WS_END) {
            fprintf(stderr, "kernel_launch: unexpected problem (n_in %d, in0 %d, out %d, ws %zu < %zu); nothing launched\n", n_in, n_in > 0 ? in_sizes[0] : -1, out_size, ws_size, (size_t)WS_END); grid = -1; return; }
        int dev = 0, cus = 0, per_cu = 0;
        if (hipGetDevice(&dev) != hipSuccess || hipDeviceGetAttribute(&cus, hipDeviceAttributeMultiprocessorCount, dev) != hipSuccess) { grid = -1; return; }
        if (hipFuncSetAttribute((const void*)mk_fwd, hipFuncAttributeMaxDynamicSharedMemorySize, LDS_BYTES) != hipSuccess) { fprintf(stderr, "kernel_launch: hipFuncSetAttribute failed\n"); grid = -1; return; }
        if (hipOccupancyMaxActiveBlocksPerMultiprocessor(&per_cu, (const void*)mk_fwd, 512, LDS_BYTES) != hipSuccess || per_cu < 1)
            fprintf(stderr, "kernel_launch: occupancy query reports %d workgroups per CU\n", per_cu);
        (void)hipGetLastError();
        grid = cus;
    }
    if (grid < 0) return;
    if (hipMemsetAsync((char*)d_ws + WS_CTL, 0, CTL_ZERO_BYTES, stream) != hipSuccess) return;
    Args a{};
    for (int i = 0; i < 22; ++i) a.in[i] = (const float*)d_in[i];
    a.out = (float*)d_out; a.ws = (unsigned char*)d_ws;
#if MK_PER_PHASE
#ifndef PROBE_LAUNCH
#define PROBE_LAUNCH -1
#endif
    for (int p = 0; p < N_PHASES; ++p) { a.ph_lo = p; a.ph_hi = p + 1;
        for (int rep = 0; rep < (p == PROBE_LAUNCH ? 2 : 1); ++rep) {
            if (rep && p == 7) (void)hipMemsetAsync((char*)d_ws + WS_CTL + CW_GCNT * 4, 0, 64 * GCNT_PAD * 4, stream);
            hipLaunchKernelGGL(mk_fwd, dim3(grid), dim3(512), LDS_BYTES, stream, a); } }
#else
    a.ph_lo = 0; a.ph_hi = N_PHASES; hipLaunchKernelGGL(mk_fwd, dim3(grid), dim3(512), LDS_BYTES, stream, a);
#endif
}
```
